# Optimizing an MI355X kernel written in HIP

```python
import jax, jax.numpy as jnp
from jax import lax
import numpy as np

D_MODEL = 1024
BATCH = 8
SEQ = 4096
DEPTH = 2

GRID_W = 64
CTX_LEN = 256
HEAD_DIM = 64
NA_WIDTH = D_MODEL // 2
NA_HEADS = NA_WIDTH // HEAD_DIM
NA_ROWS_MAX = 8
NA_COLS = 16
NA_QB = 16
NA_KB = NA_QB + NA_COLS
RET_V_WIDTH = D_MODEL // 2
RET_HEADS = 4
RET_DV = RET_V_WIDTH // RET_HEADS
RET_DK = RET_DV // 2
RET_QK_WIDTH = RET_HEADS * RET_DK
RET_CHUNK = 128
RET_LOG2_DECAY_MIN = -5.0
RET_LOG2_DECAY_MAX = -12.0
POOL_WIDTH = D_MODEL // 2
POOL_WINDOWS = (2, 4, 8, 16)
POOL_GROUPS = 4
POOL_GROUP_WIDTH = POOL_WIDTH // POOL_GROUPS
FFN_HIDDEN = -(-8 * D_MODEL // (3 * 256)) * 256
N_MOD = 6
ROPE_BASE = 10000.0
NORM_EPS = 1e-6
GN_EPS = 1e-5
NEG_INF = -1e30
IN_WIDTHS = (NA_WIDTH, NA_WIDTH, NA_WIDTH, RET_QK_WIDTH, RET_QK_WIDTH, RET_V_WIDTH, RET_V_WIDTH,
             POOL_WIDTH, D_MODEL, D_MODEL, D_MODEL)
IN_WIDTH = 3 * NA_WIDTH + 2 * RET_QK_WIDTH + 2 * RET_V_WIDTH + POOL_WIDTH + 3 * D_MODEL

kernel_name = "hybrid_na_retention_pool_dit"


def _rms_norm(x, g):
    xf = x.astype(jnp.float32)
    y = xf * lax.rsqrt(jnp.mean(xf * xf, axis=-1, keepdims=True) + NORM_EPS)
    return (y * g.astype(jnp.float32)).astype(x.dtype)


def _modulate(h, shift, scale):
    return h * (1.0 + scale) + shift


def _split_cols(u):
    out, start = [], 0
    for w in IN_WIDTHS:
        out.append(u[..., start:start + w])
        start += w
    return out


def _heads(t, n_heads, d):
    b, n, _ = t.shape
    return t.reshape(b, n, n_heads, d).transpose(0, 2, 1, 3)


def _merge_heads(t):
    b, h, n, d = t.shape
    return t.transpose(0, 2, 1, 3).reshape(b, n, h * d)


def _rope_1d(x, pos):
    nf = x.shape[-1] // 2
    inv = ROPE_BASE ** (-jnp.arange(nf, dtype=jnp.float32) / nf)
    ang = pos[:, None] * inv[None, :]
    cos, sin = jnp.cos(ang), jnp.sin(ang)
    x1, x2 = x[..., :nf], x[..., nf:]
    return jnp.concatenate([x1 * cos - x2 * sin, x1 * sin + x2 * cos], axis=-1)


def _axial_rope(x, row, col):
    half = x.shape[-1] // 2
    return jnp.concatenate([_rope_1d(x[..., :half], row), _rope_1d(x[..., half:], col)], axis=-1)


def _dense_attn(q, k, v):
    s = jnp.einsum('bhqd,bhkd->bhqk', q * HEAD_DIM ** -0.5, k).astype(jnp.float32)
    p = jax.nn.softmax(s, axis=-1).astype(v.dtype)
    return jnp.einsum('bhqk,bhkd->bhqd', p, v)


def _na_latent(q, k, v, k_ctx, v_ctx, rpb):
    b, n, _ = q.shape
    rows = n // GRID_W
    kr = min(NA_ROWS_MAX, rows)
    ncb = GRID_W // NA_QB

    def grid(t):
        return t.reshape(b, rows, GRID_W, NA_HEADS, HEAD_DIM).transpose(1, 0, 3, 2, 4)

    qg, kg, vg = grid(q * HEAD_DIM ** -0.5), grid(k), grid(v)
    qcol = np.arange(GRID_W).reshape(ncb, NA_QB)
    kstart = np.clip(qcol[:, 0] - NA_COLS // 2, 0, GRID_W - NA_KB)
    kcol = kstart[:, None] + np.arange(NA_KB)
    wstart = np.clip(qcol - NA_COLS // 2, 0, GRID_W - NA_COLS)
    col_ok = (kcol[:, None, :] >= wstart[..., None]) & (kcol[:, None, :] < wstart[..., None] + NA_COLS)
    dcol_idx = np.clip(kcol[:, None, :] - qcol[:, :, None] + NA_COLS - 1, 0, 2 * NA_COLS - 2)
    rpb_f = rpb.astype(jnp.float32)
    nw = kr * NA_KB

    def row_block(args):
        r, q_r = args
        r0 = jnp.clip(r - kr // 2, 0, rows - kr)
        k_r = lax.dynamic_slice_in_dim(kg, r0, kr, axis=0)
        v_r = lax.dynamic_slice_in_dim(vg, r0, kr, axis=0)
        kb = k_r[:, :, :, kcol].transpose(1, 2, 3, 0, 4, 5).reshape(b, NA_HEADS, ncb, nw, HEAD_DIM)
        vb = v_r[:, :, :, kcol].transpose(1, 2, 3, 0, 4, 5).reshape(b, NA_HEADS, ncb, nw, HEAD_DIM)
        qb = q_r.reshape(b, NA_HEADS, ncb, NA_QB, HEAD_DIM)
        s_win = jnp.einsum('bhnqd,bhnkd->bhnqk', qb, kb).astype(jnp.float32)
        s_win = s_win.reshape(b, NA_HEADS, ncb, NA_QB, kr, NA_KB)
        dr_idx = r0 + jnp.arange(kr) - r + NA_ROWS_MAX - 1
        bias = rpb_f[:, dr_idx][:, :, dcol_idx].transpose(0, 2, 3, 1, 4)
        s_win = jnp.where(col_ok[:, :, None, :], s_win + bias, NEG_INF).reshape(b, NA_HEADS, ncb, NA_QB, nw)
        s_ctx = jnp.einsum('bhnqd,bhkd->bhnqk', qb, k_ctx).astype(jnp.float32)
        p = jax.nn.softmax(jnp.concatenate([s_win, s_ctx], axis=-1), axis=-1).astype(v.dtype)
        o = (jnp.einsum('bhnqk,bhnkd->bhnqd', p[..., :nw], vb)
             + jnp.einsum('bhnqk,bhkd->bhnqd', p[..., nw:], v_ctx))
        return o.reshape(b, NA_HEADS, GRID_W, HEAD_DIM)

    out = lax.map(row_block, (jnp.arange(rows), qg))
    return out.transpose(1, 0, 3, 2, 4).reshape(b, n, NA_WIDTH)


def _retention_scan(q, k, v, log_g, state0, include_diag):
    b, h, n, dk = q.shape
    dv = v.shape[-1]
    nc = n // RET_CHUNK
    qc = q.reshape(b, h, nc, RET_CHUNK, dk)
    kc = k.reshape(b, h, nc, RET_CHUNK, dk)
    vc = v.reshape(b, h, nc, RET_CHUNK, dv)
    pos = jnp.arange(RET_CHUNK, dtype=jnp.float32)
    lg = log_g[:, None, None]
    diff = pos[:, None] - pos[None, :]
    mask = (diff >= 0) if include_diag else (diff > 0)
    decay = jnp.where(mask, jnp.exp(lg * jnp.where(mask, diff, 0.0)), 0.0)
    inner = jnp.einsum('bhnqd,bhnkd->bhnqk', qc, kc) * decay[:, None]
    o_in = jnp.einsum('bhnqk,bhnkv->bhnqv', inner, vc)
    zeta = jnp.exp(lg * (RET_CHUNK - 1.0 - pos))[..., None]
    contrib = jnp.einsum('bhnkd,bhnkv->nbhdv', kc * zeta, vc)
    chunk_decay = jnp.exp(log_g * RET_CHUNK)[:, None, None]

    def step(state, ctb):
        return state * chunk_decay + ctb, state

    final, prev = lax.scan(step, state0, contrib)
    xi = jnp.exp(lg * (pos + 1.0))[..., None]
    o_cross = jnp.einsum('bhnqd,nbhdv->bhnqv', qc, prev) * xi
    return (o_in + o_cross).reshape(b, h, n, dv), final


def _bi_retention(q, k, v, lg_f, lg_b, s0_f, s0_b):
    o_f, s_f = _retention_scan(q, k, v, lg_f, s0_f, True)
    flip = lambda t: t[:, :, ::-1]
    o_b, s_b = _retention_scan(flip(q), flip(k), flip(v), lg_b, s0_b, False)
    return o_f + flip(o_b), s_f, s_b


def _ret_out(o, g, gn_g):
    mu = jnp.mean(o, axis=-1, keepdims=True)
    var = jnp.mean(jnp.square(o - mu), axis=-1, keepdims=True)
    y = _merge_heads((o - mu) * lax.rsqrt(var + GN_EPS)) * gn_g.astype(jnp.float32)
    return (jax.nn.silu(g.astype(jnp.float32)) * y).astype(g.dtype)


def _pool_mixer(u, pool_w, pool_scale):
    b, n, _ = u.shape
    uf = u.astype(jnp.float32)
    cs = jnp.concatenate([jnp.zeros((b, 1, POOL_WIDTH), jnp.float32), jnp.cumsum(uf, axis=1)], axis=1)
    t = np.arange(n)
    groups = []
    for gi, w in enumerate(POOL_WINDOWS):
        lo = np.clip(t - w // 2, 0, n)
        hi = np.clip(t - w // 2 + w, 0, n)
        sl = slice(gi * POOL_GROUP_WIDTH, (gi + 1) * POOL_GROUP_WIDTH)
        csg = cs[..., sl]
        mean = (csg[:, hi] - csg[:, lo]) / jnp.asarray(hi - lo, jnp.float32)[None, :, None]
        groups.append(mean - uf[..., sl])
    pooled = jnp.stack(groups, axis=2).astype(u.dtype)
    y = jnp.einsum('bngc,gcd->bngd', pooled, pool_w).reshape(b, n, POOL_WIDTH)
    return y * pool_scale


def _merge(a, r, p, ga, gb, gc, wpa, wpb, wpc, wo):
    m = (jax.nn.sigmoid(ga) * (a @ wpa) + jax.nn.sigmoid(gb) * (r @ wpb)
         + jax.nn.sigmoid(gc) * (p @ wpc))
    return m @ wo


def _swiglu(h, wg, wu, wd):
    return (jax.nn.silu(h @ wg) * (h @ wu)) @ wd


def _token_mixers(hx, hc, w_in, rpb, logit_f, logit_b, gn_g, pool_w, pool_scale,
                  wpa, wpb, wpc, wo, with_ctx):
    b, n, _ = hx.shape
    ux = _split_cols(hx @ w_in)
    uc = _split_cols(hc @ w_in)
    f32 = jnp.float32
    k_na_c = _heads(uc[1], NA_HEADS, HEAD_DIM)
    v_na_c = _heads(uc[2], NA_HEADS, HEAD_DIM)
    a_x = _na_latent(ux[0], ux[1], ux[2], k_na_c, v_na_c, rpb)
    lg_f = jax.nn.log_sigmoid(logit_f.astype(f32))
    lg_b = jax.nn.log_sigmoid(logit_b.astype(f32))
    ksc = RET_DK ** -0.5
    q_rc = _heads(uc[3], RET_HEADS, RET_DK).astype(f32)
    k_rc = _heads(uc[4], RET_HEADS, RET_DK).astype(f32) * ksc
    v_rc = _heads(uc[5], RET_HEADS, RET_DV).astype(f32)
    zero = jnp.zeros((b, RET_HEADS, RET_DK, RET_DV), f32)
    o_rc, s_f, s_b = _bi_retention(q_rc, k_rc, v_rc, lg_f, lg_b, zero, zero)
    tpos = jnp.arange(n)
    row = (tpos // GRID_W).astype(f32)
    col = (tpos % GRID_W).astype(f32)
    q_rx = _axial_rope(_heads(ux[3], RET_HEADS, RET_DK).astype(f32), row, col)
    k_rx = _axial_rope(_heads(ux[4], RET_HEADS, RET_DK).astype(f32), row, col) * ksc
    v_rx = _heads(ux[5], RET_HEADS, RET_DV).astype(f32)
    o_rx, _, _ = _bi_retention(q_rx, k_rx, v_rx, lg_f, lg_b, s_f, s_b)
    r_x = _ret_out(o_rx, ux[6], gn_g)
    p_x = _pool_mixer(ux[7], pool_w, pool_scale)
    mix_x = _merge(a_x, r_x, p_x, ux[8], ux[9], ux[10], wpa, wpb, wpc, wo)
    if not with_ctx:
        return mix_x, None
    a_c = _merge_heads(_dense_attn(_heads(uc[0], NA_HEADS, HEAD_DIM), k_na_c, v_na_c))
    r_c = _ret_out(o_rc, uc[6], gn_g)
    p_c = _pool_mixer(uc[7], pool_w, pool_scale)
    mix_c = _merge(a_c, r_c, p_c, uc[8], uc[9], uc[10], wpa, wpb, wpc, wo)
    return mix_x, mix_c


def setup_inputs(seed: int = 0) -> dict:
    key = jax.random.key(seed)
    ks = jax.random.split(key, 24)
    f32 = jnp.float32
    nrm = lambda k, shape, s: jax.random.normal(k, shape, f32) * s
    g0 = 1.0 - 2.0 ** np.linspace(RET_LOG2_DECAY_MIN, RET_LOG2_DECAY_MAX, RET_HEADS)
    logit0 = jnp.asarray(np.log(g0) - np.log1p(-g0), f32)
    L = DEPTH
    return {
        "x": nrm(ks[0], (BATCH, SEQ, D_MODEL), 1.0),
        "c": nrm(ks[1], (BATCH, D_MODEL), 1.0),
        "ctx": nrm(ks[2], (BATCH, CTX_LEN, D_MODEL), 1.0),
        "c_ctx": nrm(ks[3], (D_MODEL,), 1.0),
        "norm1_g": 1.0 + nrm(ks[4], (L, D_MODEL), 0.02),
        "norm2_g": 1.0 + nrm(ks[5], (L, D_MODEL), 0.02),
        "w_ada": nrm(ks[6], (L, D_MODEL, N_MOD * D_MODEL), 0.5 * D_MODEL ** -0.5),
        "b_ada": nrm(ks[7], (L, N_MOD * D_MODEL), 0.02),
        "w_in": nrm(ks[8], (L, D_MODEL, IN_WIDTH), D_MODEL ** -0.5),
        "na_rpb": nrm(ks[9], (L, NA_HEADS, 2 * NA_ROWS_MAX - 1, 2 * NA_COLS - 1), 0.05),
        "ret_logit_f": logit0 + nrm(ks[10], (L, RET_HEADS), 0.1),
        "ret_logit_b": logit0 + nrm(ks[11], (L, RET_HEADS), 0.1),
        "ret_gn_g": 1.0 + nrm(ks[12], (L, RET_V_WIDTH), 0.02),
        "pool_w": nrm(ks[13], (L, POOL_GROUPS, POOL_GROUP_WIDTH, POOL_GROUP_WIDTH), POOL_GROUP_WIDTH ** -0.5),
        "pool_scale": 1.0 + nrm(ks[14], (L, POOL_WIDTH), 0.02),
        "w_branch_a": nrm(ks[15], (L, NA_WIDTH, D_MODEL), NA_WIDTH ** -0.5),
        "w_branch_b": nrm(ks[16], (L, RET_V_WIDTH, D_MODEL), RET_V_WIDTH ** -0.5),
        "w_branch_c": nrm(ks[17], (L, POOL_WIDTH, D_MODEL), POOL_WIDTH ** -0.5),
        "w_out": nrm(ks[18], (L, D_MODEL, D_MODEL), D_MODEL ** -0.5),
        "w_ffn_gate": nrm(ks[19], (L, D_MODEL, FFN_HIDDEN), D_MODEL ** -0.5),
        "w_ffn_up": nrm(ks[20], (L, D_MODEL, FFN_HIDDEN), D_MODEL ** -0.5),
        "w_ffn_down": nrm(ks[21], (L, FFN_HIDDEN, D_MODEL), FFN_HIDDEN ** -0.5),
        "final_norm_g": 1.0 + nrm(ks[22], (D_MODEL,), 0.02),
    }


def reference(x, c, ctx, c_ctx, norm1_g, norm2_g, w_ada, b_ada, w_in, na_rpb, ret_logit_f,
              ret_logit_b, ret_gn_g, pool_w, pool_scale, w_branch_a, w_branch_b, w_branch_c,
              w_out, w_ffn_gate, w_ffn_up, w_ffn_down, final_norm_g):
    b = x.shape[0]
    h, hc = x, ctx
    silu_c = jax.nn.silu(c)
    silu_cc = jax.nn.silu(c_ctx)
    for l in range(DEPTH):
        with_ctx = l < DEPTH - 1
        mx = (silu_c @ w_ada[l] + b_ada[l]).reshape(b, N_MOD, 1, D_MODEL)
        mc = (silu_cc @ w_ada[l] + b_ada[l]).reshape(N_MOD, 1, 1, D_MODEL)
        hx_n = _modulate(_rms_norm(h, norm1_g[l]), mx[:, 0], mx[:, 1])
        hc_n = _modulate(_rms_norm(hc, norm1_g[l]), mc[0], mc[1])
        mix_x, mix_c = _token_mixers(hx_n, hc_n, w_in[l], na_rpb[l], ret_logit_f[l], ret_logit_b[l],
                                     ret_gn_g[l], pool_w[l], pool_scale[l], w_branch_a[l],
                                     w_branch_b[l], w_branch_c[l], w_out[l], with_ctx)
        h = h + mx[:, 2] * mix_x
        f_x = _modulate(_rms_norm(h, norm2_g[l]), mx[:, 3], mx[:, 4])
        h = h + mx[:, 5] * _swiglu(f_x, w_ffn_gate[l], w_ffn_up[l], w_ffn_down[l])
        if with_ctx:
            hc = hc + mc[2] * mix_c
            f_c = _modulate(_rms_norm(hc, norm2_g[l]), mc[3], mc[4])
            hc = hc + mc[5] * _swiglu(f_c, w_ffn_gate[l], w_ffn_up[l], w_ffn_down[l])
    return _rms_norm(h, final_norm_g)
```

```cpp
#include <hip/hip_runtime.h>
#include <hip/hip_cooperative_groups.h>
#include <cstdio>
#include <cstdint>
namespace cg = cooperative_groups;

#ifndef REP0
#define REP0 1
#endif
#ifndef REP1
#define REP1 1
#endif
#ifndef REP2
#define REP2 1
#endif
#ifndef REP3
#define REP3 1
#endif
#ifndef REP4
#define REP4 1
#endif
#ifndef REP5
#define REP5 1
#endif
#ifndef REP6
#define REP6 1
#endif
#ifndef REP7
#define REP7 1
#endif
#ifndef REP8
#define REP8 1
#endif
#ifndef REP9
#define REP9 1
#endif
#ifndef REP10
#define REP10 1
#endif
#ifndef REP11
#define REP11 1
#endif
#ifndef REP12
#define REP12 1
#endif
#ifndef REP_POOL
#define REP_POOL 1
#endif
#ifndef REP_CON
#define REP_CON 1
#endif
#ifndef REP_NA
#define REP_NA 1
#endif
#ifndef REP_PC
#define REP_PC 1
#endif
#ifndef NSYNC
#define NSYNC 1
#endif
#ifndef MK_PER_PHASE
#define MK_PER_PHASE 0
#endif

#ifndef PG8_WGM
#define PG8_WGM 8
#endif
namespace pg8 {
#define PG8_LAS __attribute__((address_space(3)))
typedef unsigned short bf16_t;
typedef short bf16x8 __attribute__((ext_vector_type(8)));
typedef float f32x4 __attribute__((ext_vector_type(4)));
typedef unsigned u32x4 __attribute__((ext_vector_type(4)));
constexpr int BM = 256, BK = 64, HALF = 128, HTB = HALF * BK * 2  , STAGE_BYTES = 8 * HTB, NXCD = 8, WGM = PG8_WGM;

__host__ __device__ __forceinline__ int lds_byte(int r, int c) { const int st = (r >> 4) * 2 + (c >> 5), rr = r & 15, cc = c & 31, ob = rr * 64 + cc * 2; return st * 1024 + (ob ^ (((ob >> 9) & 1) << 5)); }
__host__ __device__ __forceinline__ void stage_rc(int b, int& R, int& C) { const int st = b / 1024, sb = b % 1024, swz = sb ^ (((sb >> 9) & 1) << 5); R = (st >> 1) * 16 + swz / 64; C = (st & 1) * 32 + (swz % 64) / 2; }
__host__ __device__ __forceinline__ int perm32(int rho) { const int n = rho >> 4, i = rho & 15; return 8 * (i >> 2) + 4 * n + (i & 3); }

struct Unit { int pm, pn, sub; };
struct Gemm { const bf16_t* A; const bf16_t* Bt; long sa, sb; int M, N, K; };
__device__ __forceinline__ const bf16_t* selA(const Gemm& g, int s) { return g.A + (long)s * g.sa; }
__device__ __forceinline__ const bf16_t* selB(const Gemm& g, int s) { return g.Bt + (long)s * g.sb; }

struct StaticOrder {
    int nM, nN, nwg, G, c;
    __host__ __device__ __forceinline__ void init(int M, int N, int G_, int c_) { nM = M / BM; nN = N / BM; nwg = nM * nN; G = G_; c = c_; }
    __host__ __device__ __forceinline__ void map(int L, Unit& u) const {
        int wgid = L; { const int q = nwg / NXCD, r = nwg % NXCD, xcd = wgid % NXCD, off = wgid / NXCD; wgid = (xcd < r ? xcd * (q + 1) : r * (q + 1) + (xcd - r) * q) + off; }
        const int nig = WGM * nN, gid = wgid / nig, fm = gid * WGM, gsz = (nM - fm) < WGM ? (nM - fm) : WGM;
        u.pm = fm + ((wgid % nig) % gsz); u.pn = (wgid % nig) / gsz; u.sub = 0;
    }
    __host__ __device__ __forceinline__ bool next(int i, Unit& u) const {
        const long L = (long)i * G + c; if (L >= nwg) return false;
        map((int)L, u); return true;
    }
    __device__ __forceinline__ void a_ready(const Unit&) const {}
    __device__ __forceinline__ void done(const Unit&) const {}
};
struct InprojOrder {
    StaticOrder SA, SB; int lo, nA, nB, G, c;
    __device__ __forceinline__ bool next(int i, Unit& u) const {
        const int L = i * G + c;
        if (L < nA) { SA.map(lo + L, u); u.sub = 0; return true; }
        if (L - nA < nB) { SB.map(L - nA, u); u.sub = 1; return true; }
        return false;
    }
    __device__ __forceinline__ void a_ready(const Unit&) const {}
    __device__ __forceinline__ void done(const Unit&) const {}
};
struct ChainOrder {
    StaticOrder S;
    __device__ __forceinline__ bool next(int i, Unit& u) const { const int q = i / 3; if (!S.next(q, u)) return false; u.sub = i - 3 * q; return true; }
    __device__ __forceinline__ void a_ready(const Unit&) const {}
    __device__ __forceinline__ void done(const Unit&) const {}
};
__device__ __forceinline__ unsigned cvt_pk_bf16(float lo, float hi) { unsigned r; asm volatile("v_cvt_pk_bf16_f32 %0, %1, %2" : "=v"(r) : "v"(lo), "v"(hi)); return r; }

template <class Epi, class Sched, bool ALIGN_EPI = false, bool SP2 = false>
__device__ __forceinline__ void gemm_phase(PG8_LAS unsigned char* lds, const Gemm g, const Sched& S, const Epi& E) {
    int tid_raw = threadIdx.x; asm volatile("" : "+v"(tid_raw)); const int tid = tid_raw, wid = __builtin_amdgcn_readfirstlane(tid >> 6), lane = tid & 63, wr = wid >> 2, wc = wid & 3, fr = lane & 15, fq = lane >> 4;
    const int K = g.K, nt = K / BK;
    unsigned voffA[2], voffB[2];
#pragma unroll
    for (int i = 0; i < 2; ++i) { int R, C; stage_rc(tid * 16 + i * 8192, R, C); const int Rb = Epi::PERM ? ((R & ~31) + perm32(R & 31)) : R;
        voffA[i] = (unsigned)(R * K + C) * 2u; voffB[i] = (unsigned)(Rb * K + C) * 2u; }
    const size_t kstep = (size_t)(BK * 2);
    const size_t hstep = (size_t)HALF * K * 2;
    const size_t tstep = 2 * hstep;
    const unsigned ldsw = (unsigned)wid * 1024u;
    const int aoff = lds_byte(wr * 64 + fr, fq * 8), boff = lds_byte(wc * 32 + fr, fq * 8);
#define PG8_SA(b, h) (((b) * 2 + (h)) * HTB)
#define PG8_SB(b, h) ((4 + (b) * 2 + (h)) * HTB)
#define PG8_STAGE(bufoff, gbase, voff) do { _Pragma("unroll") for (int _i = 0; _i < 2; ++_i) \
        __builtin_amdgcn_global_load_lds((const unsigned*)((const char*)(gbase) + (voff)[_i]), (PG8_LAS unsigned*)(lds + (bufoff) + ldsw + _i * 8192), 16, 0, 0); } while (0)
#define PG8_LDA(dst, b, h) do { _Pragma("unroll") for (int m = 0; m < 4; ++m) _Pragma("unroll") for (int k = 0; k < 2; ++k) dst[m][k] = *(const PG8_LAS bf16x8*)(lds + PG8_SA(b, h) + aoff + m * 2048 + k * 1024); } while (0)
#define PG8_LDB(dst, b, h) do { _Pragma("unroll") for (int n = 0; n < 2; ++n) _Pragma("unroll") for (int k = 0; k < 2; ++k) dst[n][k] = *(const PG8_LAS bf16x8*)(lds + PG8_SB(b, h) + boff + n * 2048 + k * 1024); } while (0)
#define PG8_MMA(ai, bj, At, Bt) do { __builtin_amdgcn_s_setprio(1); _Pragma("unroll") for (int m = 0; m < 4; ++m) _Pragma("unroll") for (int n = 0; n < 2; ++n) _Pragma("unroll") for (int k = 0; k < 2; ++k) \
        acc[ai][bj][m][n] = __builtin_amdgcn_mfma_f32_16x16x32_bf16(Bt[n][k], At[m][k], acc[ai][bj][m][n], 0, 0, 0); __builtin_amdgcn_s_setprio(0); } while (0)
#define PG8_WAIT_V(n) asm volatile("s_waitcnt vmcnt(" #n ")" ::: "memory")
#define PG8_WAIT_L(n) asm volatile("s_waitcnt lgkmcnt(" #n ")" ::: "memory")
#define PG8_BAR __builtin_amdgcn_s_barrier()
#define PG8_SCHED __builtin_amdgcn_sched_barrier(0)
    Unit cur, nxt; int ui = 0;
    if (!S.next(0, cur)) return;
    f32x4 acc[2][2][4][2];
#pragma unroll
    for (int a = 0; a < 2; ++a)
#pragma unroll
        for (int b = 0; b < 2; ++b)
#pragma unroll
            for (int m = 0; m < 4; ++m)
#pragma unroll
                for (int n = 0; n < 2; ++n) acc[a][b][m][n] = (f32x4){0.f, 0.f, 0.f, 0.f};
    bf16x8 At[4][2], B0[2][2], B1[2][2];
    const char* cA = (const char*)selA(g, cur.sub) + (size_t)cur.pm * tstep; const char* cB = (const char*)selB(g, cur.sub) + (size_t)cur.pn * tstep;
    S.a_ready(cur);
    if constexpr (SP2) {
        PG8_STAGE(PG8_SB(0, 0), cB, voffB); PG8_STAGE(PG8_SB(0, 1), cB + hstep, voffB); PG8_STAGE(PG8_SA(0, 0), cA, voffA); PG8_STAGE(PG8_SA(0, 1), cA + hstep, voffA);
        if (wr == 1) PG8_BAR;
        PG8_WAIT_V(2); PG8_BAR;
        PG8_STAGE(PG8_SB(1, 0), cB + kstep, voffB); PG8_STAGE(PG8_SA(1, 0), cA + kstep, voffA); PG8_STAGE(PG8_SB(1, 1), cB + hstep + kstep, voffB);
        PG8_WAIT_V(6); PG8_BAR;
    } else {
        PG8_STAGE(PG8_SB(0, 0), cB, voffB); PG8_STAGE(PG8_SA(0, 0), cA, voffA); PG8_STAGE(PG8_SB(0, 1), cB + hstep, voffB); PG8_STAGE(PG8_SA(0, 1), cA + hstep, voffA);
        if (wr == 1) PG8_BAR;
        PG8_WAIT_V(4); PG8_BAR;
        PG8_STAGE(PG8_SB(1, 0), cB + kstep, voffB); PG8_STAGE(PG8_SA(1, 0), cA + kstep, voffA); PG8_STAGE(PG8_SB(1, 1), cB + hstep + kstep, voffB);
        PG8_WAIT_V(6); PG8_BAR;
    }
    for (;;) {
        const bool has_next = S.next(ui + 1, nxt);
        const char* nA = has_next ? (const char*)selA(g, nxt.sub) + (size_t)nxt.pm * tstep : cA; const char* nB = has_next ? (const char*)selB(g, nxt.sub) + (size_t)nxt.pn * tstep : cB;
        for (int t = 0; t < nt; t += 2) {
            const bool last = (t == nt - 2);
            const char* a1 = cA + (size_t)(t + 1) * kstep;
            const char* a2 = last ? nA : cA + (size_t)(t + 2) * kstep; const char* b2 = last ? nB : cB + (size_t)(t + 2) * kstep;
            const char* a3 = a2 + kstep; const char* b3 = b2 + kstep;
            if (last && has_next) S.a_ready(nxt);
            if constexpr (SP2) {
            PG8_LDB(B0, 0, 0); PG8_LDB(B1, 0, 1); PG8_SCHED; PG8_LDA(At, 0, 0); PG8_STAGE(PG8_SA(1, 1), a1 + hstep, voffA);
            PG8_WAIT_V(8); PG8_WAIT_L(0); PG8_BAR; PG8_MMA(0, 0, At, B0); PG8_MMA(0, 1, At, B1); PG8_BAR; PG8_SCHED;
            PG8_LDA(At, 0, 1); PG8_STAGE(PG8_SB(0, 0), b2, voffB); PG8_STAGE(PG8_SB(0, 1), b2 + hstep, voffB); PG8_STAGE(PG8_SA(0, 0), a2, voffA);
            PG8_WAIT_V(8); PG8_WAIT_L(0); PG8_BAR; PG8_MMA(1, 0, At, B0); PG8_MMA(1, 1, At, B1); PG8_BAR; PG8_SCHED;
            PG8_LDB(B0, 1, 0); PG8_LDB(B1, 1, 1); PG8_SCHED; PG8_LDA(At, 1, 0); PG8_STAGE(PG8_SA(0, 1), a2 + hstep, voffA);
            PG8_WAIT_V(8); PG8_WAIT_L(0); PG8_BAR; PG8_MMA(0, 0, At, B0); PG8_MMA(0, 1, At, B1); PG8_BAR; PG8_SCHED;
            PG8_LDA(At, 1, 1); PG8_STAGE(PG8_SB(1, 0), b3, voffB); PG8_STAGE(PG8_SB(1, 1), b3 + hstep, voffB); PG8_STAGE(PG8_SA(1, 0), a3, voffA);
            PG8_WAIT_V(8); PG8_WAIT_L(0); PG8_BAR; PG8_MMA(1, 0, At, B0); PG8_MMA(1, 1, At, B1); PG8_BAR; PG8_SCHED;
            } else {
            PG8_LDB(B0, 0, 0); PG8_SCHED; PG8_LDA(At, 0, 0); PG8_STAGE(PG8_SA(1, 1), a1 + hstep, voffA);
            PG8_WAIT_L(8); PG8_BAR; PG8_WAIT_L(0); PG8_MMA(0, 0, At, B0); PG8_BAR; PG8_SCHED;
            PG8_LDB(B1, 0, 1); PG8_STAGE(PG8_SB(0, 0), b2, voffB);
            PG8_BAR; PG8_WAIT_L(0); PG8_MMA(0, 1, At, B1); PG8_BAR;
            PG8_LDA(At, 0, 1); PG8_STAGE(PG8_SA(0, 0), a2, voffA);
            PG8_BAR; PG8_WAIT_L(0); PG8_MMA(1, 0, At, B0); PG8_BAR; PG8_SCHED;
            PG8_STAGE(PG8_SB(0, 1), b2 + hstep, voffB);
            PG8_WAIT_V(6); PG8_BAR; PG8_MMA(1, 1, At, B1); PG8_BAR;
            PG8_LDB(B0, 1, 0); PG8_SCHED; PG8_LDA(At, 1, 0); PG8_STAGE(PG8_SA(0, 1), a2 + hstep, voffA);
            PG8_WAIT_L(8); PG8_BAR; PG8_WAIT_L(0); PG8_MMA(0, 0, At, B0); PG8_BAR; PG8_SCHED;
            PG8_LDB(B1, 1, 1); PG8_STAGE(PG8_SB(1, 0), b3, voffB);
            PG8_BAR; PG8_WAIT_L(0); PG8_MMA(0, 1, At, B1); PG8_BAR;
            PG8_LDA(At, 1, 1); PG8_STAGE(PG8_SA(1, 0), a3, voffA);
            PG8_BAR; PG8_WAIT_L(0); PG8_MMA(1, 0, At, B0); PG8_BAR; PG8_SCHED;
            PG8_STAGE(PG8_SB(1, 1), b3 + hstep, voffB);
            PG8_WAIT_V(6); PG8_BAR; PG8_MMA(1, 1, At, B1); PG8_BAR;
            }
        }
        if constexpr (ALIGN_EPI) { if (wr == 0) PG8_BAR; }
        if constexpr (!Epi::AFTER_DRAIN) { E(acc, cur, wr, wc, fr, fq); S.done(cur); }
        if (!has_next) break;
        if (!(Epi::CHAIN && nxt.sub != 0))
#pragma unroll
        for (int a = 0; a < 2; ++a)
#pragma unroll
            for (int b = 0; b < 2; ++b)
#pragma unroll
                for (int m = 0; m < 4; ++m)
#pragma unroll
                    for (int n = 0; n < 2; ++n) acc[a][b][m][n] = (f32x4){0.f, 0.f, 0.f, 0.f};
        cur = nxt; cA = nA; cB = nB; ++ui;
        if constexpr (ALIGN_EPI) { if (wr == 1) PG8_BAR; }
    }
    PG8_WAIT_V(0);
    if constexpr (!ALIGN_EPI) { if (wr == 0) PG8_BAR; }
    PG8_BAR;
    if constexpr (Epi::AFTER_DRAIN) { E.fused(acc, cur, wr, wc, fr, fq, lds, wid, lane); S.done(cur); }
#undef PG8_SA
#undef PG8_SB
#undef PG8_STAGE
#undef PG8_LDA
#undef PG8_LDB
#undef PG8_MMA
#undef PG8_WAIT_V
#undef PG8_WAIT_L
#undef PG8_BAR
#undef PG8_SCHED
}

}

constexpr int NWAVES = 8;
constexpr int D = 1024, NBATCH = 8, SEQ = 4096, CTXL = 256, INW = 6656, FF = 2816;
constexpr int HB = 4;
constexpr int LROWS = HB * SEQ, CROWS = HB * CTXL, HROWS = LROWS + CROWS;
constexpr int TLAT = NBATCH * SEQ, TCTX = NBATCH * CTXL, TROWS = TLAT + TCTX;
constexpr int NMODC = 6 * D;

constexpr size_t MiB = 1u << 20;
constexpr size_t WS_BAR = 16 * 1024;
constexpr size_t WS_MOD = 64 * 1024;
constexpr size_t WS_RT = 512 * 1024;
constexpr size_t WS_W = 1 * MiB, WL_STRIDE = 35 * MiB;
constexpr size_t W_IN = 0, W_BA = 13 * MiB, W_BB = 14 * MiB, W_BC = 15 * MiB, W_O = 16 * MiB, W_GU = 18 * MiB, W_D = 29 * MiB, W_P = 34 * MiB + 512 * 1024;
constexpr size_t WS_HC = 71 * MiB;
constexpr size_t WS_XN = 79 * MiB;
constexpr size_t WS_U = 147 * MiB;
constexpr size_t U_QN = 0, U_KN = 17 * MiB, U_VT = 34 * MiB, U_VTC = 50 * MiB, U_QR = 51 * MiB, U_KR = 59 * MiB + 512 * 1024, U_KTF = 68 * MiB, U_KTFC = 76 * MiB,
                 U_KTB = 76 * MiB + 512 * 1024, U_KTBC = 84 * MiB + 512 * 1024, U_VTR = 85 * MiB, U_VTRC = 101 * MiB, U_GR = 102 * MiB, U_UP = 119 * MiB, U_G = 136 * MiB;
constexpr size_t WS_ARP = 385 * MiB;
constexpr size_t WS_ST = 436 * MiB, WS_PREV = 470 * MiB, WS_END = 487 * MiB;
constexpr size_t XN_HALF = 34 * MiB;
constexpr size_t WS_FX = WS_ARP;
constexpr size_t WS_HD = WS_U;

constexpr int IP_TAIL = 480;
constexpr int LDS_BYTES = 131072 + 1024;

#define LAS __attribute__((address_space(3)))
typedef unsigned short bf16;
typedef short bf16x8 __attribute__((ext_vector_type(8)));
typedef float f32x4 __attribute__((ext_vector_type(4)));
typedef float f32x2 __attribute__((ext_vector_type(2)));
typedef unsigned u32x4 __attribute__((ext_vector_type(4)));
typedef unsigned u32x2 __attribute__((ext_vector_type(2)));
#ifndef ALIGN_SMALL
#define ALIGN_SMALL true
#endif
#ifndef WT8
#define WT8 0
#endif
#if WT8
#define ST8(p, w) __hip_atomic_store((unsigned long long*)(p), __builtin_bit_cast(unsigned long long, (w)), __ATOMIC_RELAXED, __HIP_MEMORY_SCOPE_AGENT)
#else
#define ST8(p, w) (*(u32x2*)(p) = (w))
#endif
#define MMA16(a, b, c) __builtin_amdgcn_mfma_f32_16x16x32_bf16(a, b, c, 0, 0, 0)
#define LOG2E 1.4426950408889634f

__device__ __forceinline__ unsigned pk2(float lo, float hi) { return pg8::cvt_pk_bf16(lo, hi); }
__device__ __forceinline__ float bflo(unsigned w) { return __uint_as_float(w << 16); }
__device__ __forceinline__ float bfhi(unsigned w) { return __uint_as_float(w & 0xffff0000u); }
__device__ __forceinline__ bf16x8 ld16(const bf16* p) { return *(const bf16x8*)p; }
__device__ __forceinline__ unsigned short bf1(float v) { return (unsigned short)(pk2(v, 0.f) & 0xffffu); }
__device__ __forceinline__ float wave_sum(float v) {
#pragma unroll
    for (int o = 1; o < 64; o <<= 1) v += __shfl_xor(v, o);
    return v;
}
__device__ __forceinline__ float lg2_of_logit(float logit) { return -log1pf(expf(-logit)) * LOG2E; }
__device__ __forceinline__ float enx(float g) { return __builtin_amdgcn_exp2f(__builtin_amdgcn_fmed3f(g, -30.f, 30.f) * -LOG2E); }
__device__ __forceinline__ float sigm(float g) { return __builtin_amdgcn_rcpf(1.f + enx(g)); }
__device__ __forceinline__ float sigratio(float a, float b) { return (1.f + enx(b)) * __builtin_amdgcn_rcpf(1.f + enx(a)); }

__device__ __forceinline__ float dppx1(float v) { return __builtin_bit_cast(float, __builtin_amdgcn_mov_dpp(__builtin_bit_cast(int, v), 0xB1, 0xF, 0xF, true)); }
__device__ __forceinline__ float dppx2(float v) { return __builtin_bit_cast(float, __builtin_amdgcn_mov_dpp(__builtin_bit_cast(int, v), 0x4E, 0xF, 0xF, true)); }
__device__ __forceinline__ f32x4 quad_transpose(f32x4 v, bool b0, bool b1) {
    const float r0 = dppx1(b0 ? v[0] : v[1]), r1 = dppx1(b0 ? v[2] : v[3]);
    const float x0 = b0 ? r0 : v[0], x1 = b0 ? v[1] : r0, x2 = b0 ? r1 : v[2], x3 = b0 ? v[3] : r1;
    const float q0 = dppx2(b1 ? x0 : x2), q1 = dppx2(b1 ? x1 : x3);
    f32x4 w; w[0] = b1 ? q0 : x0; w[1] = b1 ? q1 : x1; w[2] = b1 ? x2 : q0; w[3] = b1 ? x3 : q1; return w;
}

struct EpiInproj {
    static constexpr bool PERM = false, AFTER_DRAIN = false, CHAIN = false;
    unsigned char* U;
#define EPI_FENCE() asm volatile("" ::: "memory")
    __device__ __forceinline__ void operator()(f32x4 (&acc)[2][2][4][2], const pg8::Unit& u, int wr, int wc, int fr, int fq) const {
        const int pn = u.pn + (u.sub ? 14 : 0);
        const bool isctx = u.pm >= 64;
        const int bl = isctx ? (u.pm - 64) : (u.pm >> 4);
        const int nseq = isctx ? CTXL : SEQ;
        const int tb = (isctx ? 0 : ((u.pm & 15) * 256)) + wr * 64 + fr;
        const int rbase = u.pm * 256 + wr * 64 + fr;
        if (pn < 4 || pn >= 10) {
            bf16* dst; int ld = 512, c0;
            if (pn < 2) { dst = (bf16*)(U + U_QN); c0 = pn * 256; }
            else if (pn < 4) { dst = (bf16*)(U + U_KN); c0 = (pn - 2) * 256; }
            else if (pn < 12) { dst = (bf16*)(U + U_GR); c0 = (pn - 10) * 256; }
            else if (pn < 14) { dst = (bf16*)(U + U_UP); c0 = (pn - 12) * 256; }
            else { dst = (bf16*)(U + U_G); c0 = (pn - 14) * 256; ld = 3072; }
            bf16* rp0 = dst + (size_t)rbase * ld + c0 + wc * 32 + fq * 4;
#pragma unroll
            for (int ai = 0; ai < 2; ++ai)
#pragma unroll
                for (int m = 0; m < 4; ++m) { bf16* rp = rp0 + (size_t)(ai * 128 + m * 16) * ld;
#pragma unroll
                    for (int bj = 0; bj < 2; ++bj)
#pragma unroll
                        for (int n = 0; n < 2; ++n) { f32x4 v = acc[ai][bj][m][n]; if (pn >= 14) { v[0] = sigm(v[0]); v[1] = sigm(v[1]); v[2] = sigm(v[2]); v[3] = sigm(v[3]); }
                            u32x2 w; w.x = pk2(v[0], v[1]); w.y = pk2(v[2], v[3]); ST8(rp + bj * 128 + n * 16, w); }
                    EPI_FENCE(); }
        } else if (pn < 6 || pn >= 8) {
            const bool nav = pn < 6;
            bf16* dst = (bf16*)(U + (nav ? (isctx ? U_VTC : U_VT) : (isctx ? U_VTRC : U_VTR)));
            const int ccb = (nav ? (pn - 4) : (pn - 8)) * 256 + wc * 32 + fq * 4 + (fr & 3);
            const bool b0 = (fr & 1) != 0, b1 = (fr & 2) != 0;
            bf16* bp0 = dst + (size_t)(bl * 512 + ccb) * nseq + (tb - fr) + 4 * (fr >> 2);
#pragma unroll
            for (int bj = 0; bj < 2; ++bj)
#pragma unroll
                for (int n = 0; n < 2; ++n) { bf16* bp = bp0 + (size_t)(bj * 128 + n * 16) * nseq;
#pragma unroll
                    for (int ai = 0; ai < 2; ++ai)
#pragma unroll
                        for (int m = 0; m < 4; ++m) { const f32x4 w4 = quad_transpose(acc[ai][bj][m][n], b0, b1); u32x2 w; w.x = pk2(w4[0], w4[1]); w.y = pk2(w4[2], w4[3]); *(u32x2*)(bp + ai * 128 + m * 16) = w; }
                    EPI_FENCE(); }
        }
        else {
            bf16* rp0 = (bf16*)(U + (pn == 6 ? U_QR : U_KR)) + (size_t)rbase * 256 + wc * 32 + fq * 4;
#pragma unroll
            for (int ai = 0; ai < 2; ++ai)
#pragma unroll
                for (int m = 0; m < 4; ++m) { bf16* rp = rp0 + (size_t)(ai * 128 + m * 16) * 256;
#pragma unroll
                    for (int bj = 0; bj < 2; ++bj)
#pragma unroll
                        for (int n = 0; n < 2; ++n) { const f32x4 v = acc[ai][bj][m][n]; u32x2 w; w.x = pk2(v[0], v[1]); w.y = pk2(v[2], v[3]); ST8(rp + bj * 128 + n * 16, w); }
                    EPI_FENCE(); }
        }
    }
};

struct EpiNull { static constexpr bool PERM = false, AFTER_DRAIN = false, CHAIN = false; float* sink;
    __device__ __forceinline__ void operator()(f32x4 (&acc)[2][2][4][2], const pg8::Unit& u, int wr, int wc, int fr, int fq) const { f32x4 s = {0.f, 0.f, 0.f, 0.f};
#pragma unroll
        for (int a = 0; a < 2; ++a)
#pragma unroll
            for (int b = 0; b < 2; ++b)
#pragma unroll
                for (int m = 0; m < 4; ++m)
#pragma unroll
                    for (int n = 0; n < 2; ++n) s += acc[a][b][m][n];
        if (s[0] + s[1] + s[2] + s[3] == 1.2345e-33f) sink[0] = 1.f; } };

struct EpiMerge {
    static constexpr bool PERM = false, AFTER_DRAIN = false, CHAIN = true;
    const bf16* G; bf16* Mo;
    __device__ __forceinline__ void operator()(f32x4 (&acc)[2][2][4][2], const pg8::Unit& u, int wr, int wc, int fr, int fq) const {
        const int rbase = u.pm * 256 + wr * 64 + fr, c0 = u.pn * 256 + wc * 32 + fq * 4, sub = u.sub;
#pragma unroll
        for (int ai = 0; ai < 2; ++ai)
#pragma unroll
            for (int m = 0; m < 4; ++m) { const size_t row = (size_t)(rbase + ai * 128 + m * 16); const bf16* gp = G + row * 3072 + c0;
#pragma unroll
                for (int bj = 0; bj < 2; ++bj)
#pragma unroll
                    for (int n = 0; n < 2; ++n) { const int co = bj * 128 + n * 16; f32x4 v = acc[ai][bj][m][n];
                        if (sub < 2) { const u32x2 a = *(const u32x2*)(gp + sub * 1024 + co), b = *(const u32x2*)(gp + (sub + 1) * 1024 + co);
                            v[0] *= bflo(a.x) * __builtin_amdgcn_rcpf(bflo(b.x)); v[1] *= bfhi(a.x) * __builtin_amdgcn_rcpf(bfhi(b.x)); v[2] *= bflo(a.y) * __builtin_amdgcn_rcpf(bflo(b.y)); v[3] *= bfhi(a.y) * __builtin_amdgcn_rcpf(bfhi(b.y));
                            acc[ai][bj][m][n] = v; }
                        else { const u32x2 a = *(const u32x2*)(gp + 2048 + co);
                            v[0] *= bflo(a.x); v[1] *= bfhi(a.x); v[2] *= bflo(a.y); v[3] *= bfhi(a.y);
                            u32x2 w; w.x = pk2(v[0], v[1]); w.y = pk2(v[2], v[3]); ST8(Mo + row * 1024 + c0 + co, w); } } }
    }
};

struct EpiResid {
    static constexpr bool PERM = false, AFTER_DRAIN = false, CHAIN = false;
    const float* base_lat; const float* base_ctx; float* out_lat; float* out_ctx; const float* mod; int lat_tiles, off_lat, off_ctx;
    __device__ __forceinline__ void operator()(f32x4 (&acc)[2][2][4][2], const pg8::Unit& u, int wr, int wc, int fr, int fq) const {
        const bool isctx = u.pm >= lat_tiles;
        const int r0 = (isctx ? off_ctx + (u.pm - lat_tiles) * 256 : off_lat + u.pm * 256);
        const int bidx = isctx ? 8 : (r0 >> 12);
        const float* bp = isctx ? base_ctx : base_lat; float* op = isctx ? out_ctx : out_lat;
        const int c0 = u.pn * 256 + wc * 32 + fq * 4;
        f32x4 mv[2][2];
#pragma unroll
        for (int bj = 0; bj < 2; ++bj)
#pragma unroll
            for (int n = 0; n < 2; ++n) mv[bj][n] = *(const f32x4*)(mod + bidx * NMODC + c0 + bj * 128 + n * 16);
#pragma unroll
        for (int ai = 0; ai < 2; ++ai)
#pragma unroll
            for (int m = 0; m < 4; ++m) { const size_t off = (size_t)(r0 + wr * 64 + fr + ai * 128 + m * 16) * D + c0;
#pragma unroll
                for (int bj = 0; bj < 2; ++bj)
#pragma unroll
                    for (int n = 0; n < 2; ++n) { const f32x4 b = *(const f32x4*)(bp + off + bj * 128 + n * 16); *(f32x4*)(op + off + bj * 128 + n * 16) = b + mv[bj][n] * acc[ai][bj][m][n]; } }
    }
};

struct EpiFfn1 {
    static constexpr bool PERM = false, AFTER_DRAIN = false, CHAIN = false;
    bf16* Hd;
    __device__ __forceinline__ void operator()(f32x4 (&acc)[2][2][4][2], const pg8::Unit& u, int wr, int wc, int fr, int fq) const {
        const int rbase = u.pm * 256 + wr * 64 + fr;
#pragma unroll
        for (int ai = 0; ai < 2; ++ai)
#pragma unroll
            for (int m = 0; m < 4; ++m) { bf16* rp = Hd + (size_t)(rbase + ai * 128 + m * 16) * FF + (u.pn * 256 + wc * 32) / 2 + fq * 4;
#pragma unroll
                for (int bj = 0; bj < 2; ++bj) { const f32x4 g = acc[ai][bj][m][0], up = acc[ai][bj][m][1]; f32x4 h;
#pragma unroll
                    for (int j = 0; j < 4; ++j) h[j] = g[j] * sigm(g[j]) * up[j];
                    u32x2 w; w.x = pk2(h[0], h[1]); w.y = pk2(h[2], h[3]); ST8(rp + bj * 64, w); } }
    }
};

struct Args { const float* in[23]; float* out; unsigned char* ws; int ph_lo, ph_hi; };

__device__ __forceinline__ void transpose_item(const float* W, int K, int N, bf16* WT, int mode, LAS float* scr, int item, int lane) {
    const int nblk = N / 32, kb = item / nblk, nb = item % nblk, k0 = 64 * kb, n0 = 32 * nb;
#pragma unroll 8
    for (int i = 0; i < 32; ++i) { const int kk = 2 * i + (lane >> 5); scr[kk * 33 + (lane & 31)] = W[(size_t)(k0 + kk) * N + n0 + (lane & 31)]; }
    asm volatile("s_waitcnt lgkmcnt(0)" ::: "memory");
    const int c = lane & 7;
#pragma unroll
    for (int j = 0; j < 4; ++j) { const int n = (lane >> 3) + 8 * j; const LAS float* s = scr + (8 * c) * 33 + n;
        u32x4 o; o.x = pk2(s[0 * 33], s[1 * 33]); o.y = pk2(s[2 * 33], s[3 * 33]); o.z = pk2(s[4 * 33], s[5 * 33]); o.w = pk2(s[6 * 33], s[7 * 33]);
        const int nn = n0 + n; const int dr = (mode == 0) ? nn : (nn + 16 * (nn >> 4) + (mode == 2 ? 16 : 0));
        *(u32x4*)(WT + (size_t)dr * K + k0 + 8 * c) = o; }
    asm volatile("s_waitcnt lgkmcnt(0)" ::: "memory");
}

__device__ __forceinline__ void norm_row(const float* src, bf16* dst, const float* gam, const float* shift, const float* scale, int lane) {
    f32x4 v[4]; float ss = 0.f;
#pragma unroll
    for (int j = 0; j < 4; ++j) { v[j] = *(const f32x4*)(src + 4 * lane + 256 * j); ss += (v[j][0] * v[j][0] + v[j][1] * v[j][1]) + (v[j][2] * v[j][2] + v[j][3] * v[j][3]); }
    const float rstd = rsqrtf(wave_sum(ss) * (1.f / D) + 1e-6f);
#pragma unroll
    for (int j = 0; j < 4; ++j) { const int c = 4 * lane + 256 * j; const f32x4 g = *(const f32x4*)(gam + c), sh = *(const f32x4*)(shift + c), sc = *(const f32x4*)(scale + c);
        const f32x4 y = (v[j] * rstd * g) * (sc + 1.0f) + sh; u32x2 w; w.x = pk2(y[0], y[1]); w.y = pk2(y[2], y[3]); ST8(dst + c, w); }
}

__device__ __forceinline__ void rope_item(unsigned char* U, const float* RT, float l2f, float l2b, int row0, int h, int which, int hf0, int lane) {
    const bool isctx = row0 >= LROWS;
    const int row = row0 + lane;
    bf16* p = (bf16*)(U + (which == 0 ? U_QR : U_KR)) + (size_t)row * 256 + h * 64;
    int t, bl, n; if (!isctx) { t = row & (SEQ - 1); bl = row >> 12; n = SEQ; } else { t = (row - LROWS) & (CTXL - 1); bl = (row - LROWS) >> 8; n = CTXL; }
    const int prow = isctx ? 0 : (t >> 6), pcol = isctx ? 0 : (t & 63);
    const float sc = which == 0 ? 1.0f : 0.125f;
    const int pc = t & 127; const float wf = __builtin_amdgcn_exp2f(l2f * (float)(127 - pc)), wb = __builtin_amdgcn_exp2f(l2b * (float)pc);
    bf16* kf = (bf16*)(U + (isctx ? U_KTFC : U_KTF)) + (size_t)((bl * 4 + h) * 64) * n + t;
    bf16* kb = (bf16*)(U + (isctx ? U_KTBC : U_KTB)) + (size_t)((bl * 4 + h) * 64) * n + t;
    { const int hf = hf0;
        const int pos = hf == 0 ? prow : pcol;
        u32x4 w0 = *(const u32x4*)(p + hf * 32), w1 = *(const u32x4*)(p + hf * 32 + 8), w2 = *(const u32x4*)(p + hf * 32 + 16), w3 = *(const u32x4*)(p + hf * 32 + 24);
        float x1[16], x2[16];
#pragma unroll
        for (int i = 0; i < 4; ++i) { x1[2 * i] = bflo(w0[i]); x1[2 * i + 1] = bfhi(w0[i]); x1[8 + 2 * i] = bflo(w1[i]); x1[8 + 2 * i + 1] = bfhi(w1[i]);
            x2[2 * i] = bflo(w2[i]); x2[2 * i + 1] = bfhi(w2[i]); x2[8 + 2 * i] = bflo(w3[i]); x2[8 + 2 * i + 1] = bfhi(w3[i]); }
#pragma unroll
        for (int i = 0; i < 16; ++i) { const f32x2 cs = *(const f32x2*)(RT + (pos * 16 + i) * 2); const float a = x1[i], b = x2[i];
            x1[i] = (a * cs[0] - b * cs[1]) * sc; x2[i] = (a * cs[1] + b * cs[0]) * sc; }
#pragma unroll
        for (int i = 0; i < 4; ++i) { w0[i] = pk2(x1[2 * i], x1[2 * i + 1]); w1[i] = pk2(x1[8 + 2 * i], x1[8 + 2 * i + 1]); w2[i] = pk2(x2[2 * i], x2[2 * i + 1]); w3[i] = pk2(x2[8 + 2 * i], x2[8 + 2 * i + 1]); }
        *(u32x4*)(p + hf * 32) = w0; *(u32x4*)(p + hf * 32 + 8) = w1; *(u32x4*)(p + hf * 32 + 16) = w2; *(u32x4*)(p + hf * 32 + 24) = w3;
        if (which == 1) {
#pragma unroll
            for (int i = 0; i < 16; ++i) { kf[(size_t)(hf * 32 + i) * n] = bf1(x1[i] * wf); kb[(size_t)(hf * 32 + i) * n] = bf1(x1[i] * wb);
                kf[(size_t)(hf * 32 + 16 + i) * n] = bf1(x2[i] * wf); kb[(size_t)(hf * 32 + 16 + i) * n] = bf1(x2[i] * wb); }
        }
        EPI_FENCE();
    }
}

struct NaState { f32x4 o[4]; float mrun, l; };
template <bool ISW>
__device__ __forceinline__ void na_block(NaState& S, const bf16x8 q0, const bf16x8 q1, const bf16* Kp0, const bf16* vb, const LAS unsigned char* kl, const LAS unsigned char* vl,
                                         const LAS float* rp0, int kstart, int qc, int ws_, int fq) {
    f32x4 st[8];
    bf16x8 vw[16];
    if (ISW) {
        bf16x8 kw[16];
#pragma unroll
        for (int t = 0; t < 8; ++t) { const bf16* Kp = Kp0 + (size_t)((t >> 1) * 64 + 4 * (t & 1)) * 512; kw[2 * t] = ld16(Kp); kw[2 * t + 1] = ld16(Kp + 32); }
#pragma unroll
        for (int gi = 0; gi < 4; ++gi)
#pragma unroll
            for (int dt = 0; dt < 4; ++dt) vw[gi * 4 + dt] = ld16(vb + (size_t)dt * 16 * SEQ + gi * 64);
#pragma unroll
        for (int t = 0; t < 8; ++t) { f32x4 z = {0.f, 0.f, 0.f, 0.f}; z = MMA16(kw[2 * t], q0, z); z = MMA16(kw[2 * t + 1], q1, z); st[t] = z; }
    } else {
#pragma unroll
        for (int t = 0; t < 8; ++t) { f32x4 z = {0.f, 0.f, 0.f, 0.f};
            z = MMA16(*(const LAS bf16x8*)(kl + t * 16 * 144), q0, z); z = MMA16(*(const LAS bf16x8*)(kl + t * 16 * 144 + 64), q1, z); st[t] = z; }
    }
    float mx = -1e30f;
#pragma unroll
    for (int t = 0; t < 8; ++t) {
#pragma unroll
        for (int j = 0; j < 4; ++j) { float s = st[t][j] * 0.125f;
            if (ISW) { const int kc = kstart + 8 * fq + 4 * (t & 1) + j; const bool ok = (kc >= ws_) && (kc < ws_ + 16); const int dc = min(max(kc - qc + 15, 0), 30);
                s += rp0[(t >> 1) * 31 + dc]; s = ok ? s : -1e30f; }
            st[t][j] = s; mx = fmaxf(mx, s); } }
    mx = fmaxf(mx, __shfl_xor(mx, 16)); mx = fmaxf(mx, __shfl_xor(mx, 32));
    const float mnew = fmaxf(S.mrun, mx), resc = __builtin_amdgcn_exp2f((S.mrun - mnew) * LOG2E);
    S.mrun = mnew; float ls = 0.f;
#pragma unroll
    for (int t = 0; t < 8; ++t)
#pragma unroll
        for (int j = 0; j < 4; ++j) { const float p = __builtin_amdgcn_exp2f((st[t][j] - mnew) * LOG2E); st[t][j] = p; ls += p; }
    ls += __shfl_xor(ls, 16); ls += __shfl_xor(ls, 32);
    S.l = S.l * resc + ls;
#pragma unroll
    for (int dt = 0; dt < 4; ++dt) S.o[dt] = S.o[dt] * resc;
#pragma unroll
    for (int gi = 0; gi < 4; ++gi) { u32x4 pw; pw.x = pk2(st[2 * gi][0], st[2 * gi][1]); pw.y = pk2(st[2 * gi][2], st[2 * gi][3]); pw.z = pk2(st[2 * gi + 1][0], st[2 * gi + 1][1]); pw.w = pk2(st[2 * gi + 1][2], st[2 * gi + 1][3]);
        const bf16x8 pf = __builtin_bit_cast(bf16x8, pw);
        if (ISW) {
#pragma unroll
            for (int dt = 0; dt < 4; ++dt) S.o[dt] = MMA16(vw[gi * 4 + dt], pf, S.o[dt]);
        } else {
#pragma unroll
            for (int dt = 0; dt < 4; ++dt) S.o[dt] = MMA16(*(const LAS bf16x8*)(vl + dt * 16 * 528 + gi * 64), pf, S.o[dt]);
        } }
}
__device__ __forceinline__ void na_block_lw(NaState& S, const bf16x8 q0, const bf16x8 q1, const LAS unsigned char* Kl, const LAS unsigned char* Vl, const LAS float* rph,
                                            int rowb, int grow, int r0, int kstart, int qc, int ws_, int fr, int fq) {
    f32x4 st[8];
    const LAS unsigned char* kl = Kl + (size_t)(kstart + 8 * (fr >> 2) + (fr & 3)) * 144 + fq * 16;
#pragma unroll
    for (int t = 0; t < 8; ++t) { const LAS unsigned char* kp = kl + ((t >> 1) * 64 + 4 * (t & 1)) * 144; f32x4 z = {0.f, 0.f, 0.f, 0.f};
        z = MMA16(*(const LAS bf16x8*)kp, q0, z); z = MMA16(*(const LAS bf16x8*)(kp + 64), q1, z); st[t] = z; }
    float mx = -1e30f;
#pragma unroll
    for (int t = 0; t < 8; ++t) { const int kra = rowb + (t >> 1); const bool rowok = (kra >= r0) && (kra <= r0 + 7); const int dr = min(max(kra - grow + 7, 0), 14);
        const LAS float* rpr = rph + dr * 31;
#pragma unroll
        for (int j = 0; j < 4; ++j) { const int kc = kstart + 8 * fq + 4 * (t & 1) + j; const bool ok = rowok && (kc >= ws_) && (kc < ws_ + 16); const int dc = min(max(kc - qc + 15, 0), 30);
            float s = st[t][j] * 0.125f + rpr[dc]; s = ok ? s : -1e30f; st[t][j] = s; mx = fmaxf(mx, s); } }
    mx = fmaxf(mx, __shfl_xor(mx, 16)); mx = fmaxf(mx, __shfl_xor(mx, 32));
    const float mnew = fmaxf(S.mrun, mx), resc = __builtin_amdgcn_exp2f((S.mrun - mnew) * LOG2E);
    S.mrun = mnew; float ls = 0.f;
#pragma unroll
    for (int t = 0; t < 8; ++t)
#pragma unroll
        for (int j = 0; j < 4; ++j) { const float p = __builtin_amdgcn_exp2f((st[t][j] - mnew) * LOG2E); st[t][j] = p; ls += p; }
    ls += __shfl_xor(ls, 16); ls += __shfl_xor(ls, 32);
    S.l = S.l * resc + ls;
#pragma unroll
    for (int dt = 0; dt < 4; ++dt) S.o[dt] = S.o[dt] * resc;
    const LAS unsigned char* vl = Vl + (size_t)fr * 528 + (kstart + 8 * fq) * 2;
#pragma unroll
    for (int gi = 0; gi < 4; ++gi) { u32x4 pw; pw.x = pk2(st[2 * gi][0], st[2 * gi][1]); pw.y = pk2(st[2 * gi][2], st[2 * gi][3]); pw.z = pk2(st[2 * gi + 1][0], st[2 * gi + 1][1]); pw.w = pk2(st[2 * gi + 1][2], st[2 * gi + 1][3]);
        const bf16x8 pf = __builtin_bit_cast(bf16x8, pw);
#pragma unroll
        for (int dt = 0; dt < 4; ++dt) S.o[dt] = MMA16(*(const LAS bf16x8*)(vl + dt * 16 * 528 + gi * 128), pf, S.o[dt]); }
}
template <bool WIN>
__device__ __forceinline__ void na_item(unsigned char* U, bf16* Aout, const LAS float* rp, const LAS unsigned char* Kl, const LAS unsigned char* Vl, int bl, int h, int qrow0, int grow, int cb, int lane) {
    const int fr = lane & 15, fq = lane >> 4;
    const bf16* QN = (const bf16*)(U + U_QN); const bf16* KN = (const bf16*)(U + U_KN); const bf16* VT = (const bf16*)(U + U_VT);
    const bf16* Qp = QN + (size_t)(qrow0 + fr) * 512 + h * 64 + fq * 8;
    const bf16x8 q0 = ld16(Qp), q1 = ld16(Qp + 32);
    const int r0 = min(max(grow - 4, 0), 56), kstart = min(max(16 * cb - 8, 0), 32), koff = 8 * (fr >> 2) + (fr & 3);
    const int qc = 16 * cb + fr, ws_ = min(max(qc - 8, 0), 48);
    NaState S;
#pragma unroll
    for (int dt = 0; dt < 4; ++dt) S.o[dt] = (f32x4){0.f, 0.f, 0.f, 0.f};
    S.mrun = -1e30f; S.l = 0.f;
    if (WIN) {
#pragma unroll 1
        for (int blk = 0; blk < 2; ++blk) {
            const bf16* Kp0 = KN + (size_t)(bl * SEQ + (r0 + 4 * blk) * 64 + kstart + koff) * 512 + h * 64 + fq * 8;
            const bf16* vb = VT + (size_t)((bl * 8 + h) * 64 + fr) * SEQ + (r0 + 4 * blk) * 64 + kstart + 8 * fq;
            na_block<true>(S, q0, q1, Kp0, vb, Kl, Vl, rp + (h * 15 + (r0 + 4 * blk - grow + 7)) * 31, kstart, qc, ws_, fq);
            EPI_FENCE();
        }
    }
#pragma unroll 1
    for (int blk = 0; blk < 2; ++blk) {
        na_block<false>(S, q0, q1, KN, VT, Kl + (size_t)(128 * blk + fr) * 144 + fq * 16, Vl + (size_t)fr * 528 + (128 * blk + 8 * fq) * 2, rp, 0, 0, 0, fq);
        EPI_FENCE();
    }
    const float inv = 1.f / S.l;
    bf16* op = Aout + (size_t)(qrow0 + fr) * 512 + h * 64 + 4 * fq;
#pragma unroll
    for (int dt = 0; dt < 4; ++dt) { u32x2 w; w.x = pk2(S.o[dt][0] * inv, S.o[dt][1] * inv); w.y = pk2(S.o[dt][2] * inv, S.o[dt][3] * inv); ST8(op + dt * 16, w); }
}

template <int GI>
__device__ __forceinline__ void pool_item(unsigned char* U, const bf16* PW, const float* pscale, bf16* Pout, int row0, int lane) {
    constexpr int g = GI, W = 2 << GI, hw = 1 << GI;
    const int fr = lane & 15, fq = lane >> 4;
    const bf16* UP = (const bf16*)(U + U_UP);
    const int row = row0 + fr;
    int t, n; if (row < LROWS) { t = row & (SEQ - 1); n = SEQ; } else { t = (row - LROWS) & (CTXL - 1); n = CTXL; }
    const int sbase = row - t;
    const int lo = max(t - hw, 0), hi = min(t + hw, n);
    const float inv = 1.f / (float)(hi - lo);
    f32x4 acc[8];
#pragma unroll
    for (int dt = 0; dt < 8; ++dt) acc[dt] = (f32x4){0.f, 0.f, 0.f, 0.f};
#pragma unroll
    for (int ks = 0; ks < 4; ++ks) { const int c0 = g * 128 + ks * 32 + fq * 8;
        float s0 = 0.f, s1 = 0.f, s2 = 0.f, s3 = 0.f, s4 = 0.f, s5 = 0.f, s6 = 0.f, s7 = 0.f;
        constexpr int WC = W < 8 ? W : 8;
        const u32x4 me = *(const u32x4*)(UP + (size_t)row * 512 + c0);
#pragma unroll
        for (int i0 = 0; i0 < W; i0 += WC) {
            u32x4 wv[WC];
#pragma unroll
            for (int i = 0; i < WC; ++i) { const int tt = min(max(t - hw + i0 + i, 0), n - 1); wv[i] = *(const u32x4*)(UP + (size_t)(sbase + tt) * 512 + c0); }
#pragma unroll
            for (int i = 0; i < WC; ++i) { const int tt = t - hw + i0 + i; const float ok = (tt >= 0 && tt < n) ? 1.f : 0.f; const u32x4 v = wv[i];
                s0 += ok * bflo(v.x); s1 += ok * bfhi(v.x); s2 += ok * bflo(v.y); s3 += ok * bfhi(v.y); s4 += ok * bflo(v.z); s5 += ok * bfhi(v.z); s6 += ok * bflo(v.w); s7 += ok * bfhi(v.w); }
            EPI_FENCE();
        }
        u32x4 pw; pw.x = pk2(s0 * inv - bflo(me.x), s1 * inv - bfhi(me.x)); pw.y = pk2(s2 * inv - bflo(me.y), s3 * inv - bfhi(me.y));
        pw.z = pk2(s4 * inv - bflo(me.z), s5 * inv - bfhi(me.z)); pw.w = pk2(s6 * inv - bflo(me.w), s7 * inv - bfhi(me.w));
        const bf16x8 pf = __builtin_bit_cast(bf16x8, pw);
        EPI_FENCE();
#pragma unroll
        for (int dt = 0; dt < 8; ++dt) { const bf16x8 wf = ld16(PW + (size_t)(g * 128 + dt * 16 + fr) * 128 + ks * 32 + fq * 8); acc[dt] = MMA16(wf, pf, acc[dt]); if ((dt & 3) == 3) EPI_FENCE(); }
        }
#pragma unroll
    for (int dt = 0; dt < 8; ++dt) { const int col = g * 128 + dt * 16 + 4 * fq; const f32x4 sc = *(const f32x4*)(pscale + col); const f32x4 y = acc[dt] * sc;
        u32x2 w; w.x = pk2(y[0], y[1]); w.y = pk2(y[2], y[3]); ST8(Pout + (size_t)row * 512 + col, w); }
}

__device__ __forceinline__ void contrib_item(unsigned char* U, float* ST, int bl, int h, bool isctx, int C, int dvt, int lane) {
    const int fr = lane & 15, fq = lane >> 4;
    const int n = isctx ? CTXL : SEQ;
    const bf16* VTR = (const bf16*)(U + (isctx ? U_VTRC : U_VTR));
    bf16x8 vf[4];
#pragma unroll
    for (int ks = 0; ks < 4; ++ks) vf[ks] = ld16(VTR + (size_t)((bl * 4 + h) * 128 + dvt * 16 + fr) * n + C * 128 + ks * 32 + fq * 8);
#pragma unroll
    for (int dir = 0; dir < 2; ++dir) {
        const bf16* KT = (const bf16*)(U + (dir == 0 ? (isctx ? U_KTFC : U_KTF) : (isctx ? U_KTBC : U_KTB)));
        const int step = dir == 0 ? (isctx ? C : 2 + C) : (isctx ? 1 - C : 2 + 31 - C);
        float* sp = ST + ((size_t)(((bl * 4 + h) * 2 + dir) * 34 + step)) * 8192 + (dvt * 16 + 4 * fq) * 64 + fr;
#pragma unroll
        for (int dkt = 0; dkt < 4; ++dkt) { f32x4 a = {0.f, 0.f, 0.f, 0.f};
#pragma unroll
            for (int ks = 0; ks < 4; ++ks) { const bf16x8 kf = ld16(KT + (size_t)((bl * 4 + h) * 64 + dkt * 16 + fr) * n + C * 128 + ks * 32 + fq * 8); a = MMA16(vf[ks], kf, a); }
#pragma unroll
            for (int j = 0; j < 4; ++j) sp[j * 64 + dkt * 16] = a[j];
            EPI_FENCE(); }
    }
}

constexpr int RO_K = 0, RO_V = 18432, RO_PF = 18432 + 34816, RO_PB = RO_PF + 18432, RO_END = RO_PB + 18432;
__device__ __forceinline__ void retout_item(unsigned char* U, const LAS unsigned char* L, bf16* Rout, const float* gn, float l2f, float l2b, int bl, int h, bool isctx, int C, int qt, int lane) {
    const int fr = lane & 15, fq = lane >> 4;
    const int rowbase = isctx ? (LROWS + bl * CTXL) : bl * SEQ;
    const bf16* QR = (const bf16*)(U + U_QR); const bf16* GR = (const bf16*)(U + U_GR);
    const int row = rowbase + C * 128 + qt * 16 + fr;
    const bf16* Qp = QR + (size_t)row * 256 + h * 64 + fq * 8;
    const bf16x8 q0 = ld16(Qp), q1 = ld16(Qp + 32);
    const int nq = qt * 16 + fr;
    f32x4 st[8];
    const LAS unsigned char* kl = L + RO_K + fr * 144 + fq * 16;
#pragma unroll
    for (int t = 0; t < 8; ++t) {
        f32x4 z = {0.f, 0.f, 0.f, 0.f}; z = MMA16(*(const LAS bf16x8*)(kl + t * 16 * 144), q0, z); z = MMA16(*(const LAS bf16x8*)(kl + t * 16 * 144 + 64), q1, z);
#pragma unroll
        for (int j = 0; j < 4; ++j) { const int mm = 32 * (t >> 1) + 8 * fq + 4 * (t & 1) + j; const int dl = nq - mm; const float w = __builtin_amdgcn_exp2f(dl >= 0 ? l2f * (float)dl : l2b * (float)(-dl)); z[j] *= w; }
        st[t] = z; }
    f32x4 o[8];
#pragma unroll
    for (int dt = 0; dt < 8; ++dt) o[dt] = (f32x4){0.f, 0.f, 0.f, 0.f};
    const LAS unsigned char* vl = L + RO_V + fr * 272 + fq * 16;
#pragma unroll
    for (int gi = 0; gi < 4; ++gi) { u32x4 pw; pw.x = pk2(st[2 * gi][0], st[2 * gi][1]); pw.y = pk2(st[2 * gi][2], st[2 * gi][3]); pw.z = pk2(st[2 * gi + 1][0], st[2 * gi + 1][1]); pw.w = pk2(st[2 * gi + 1][2], st[2 * gi + 1][3]);
        const bf16x8 pf = __builtin_bit_cast(bf16x8, pw);
#pragma unroll
        for (int dt = 0; dt < 8; ++dt) o[dt] = MMA16(*(const LAS bf16x8*)(vl + dt * 16 * 272 + gi * 64), pf, o[dt]);
        EPI_FENCE(); }
    const float xf = __builtin_amdgcn_exp2f(l2f * (float)(nq + 1)), xb = __builtin_amdgcn_exp2f(l2b * (float)(128 - nq));
    const LAS unsigned char* pfl = L + RO_PF + fr * 144 + fq * 16; const LAS unsigned char* pbl = L + RO_PB + fr * 144 + fq * 16;
#pragma unroll
    for (int dt = 0; dt < 8; ++dt) { f32x4 cf = {0.f, 0.f, 0.f, 0.f}, cb = {0.f, 0.f, 0.f, 0.f};
        cf = MMA16(*(const LAS bf16x8*)(pfl + dt * 16 * 144), q0, cf); cf = MMA16(*(const LAS bf16x8*)(pfl + dt * 16 * 144 + 64), q1, cf);
        cb = MMA16(*(const LAS bf16x8*)(pbl + dt * 16 * 144), q0, cb); cb = MMA16(*(const LAS bf16x8*)(pbl + dt * 16 * 144 + 64), q1, cb);
        o[dt] = o[dt] + cf * xf + cb * xb; if (dt & 1) EPI_FENCE(); }
    float s = 0.f;
#pragma unroll
    for (int dt = 0; dt < 8; ++dt) s += (o[dt][0] + o[dt][1]) + (o[dt][2] + o[dt][3]);
    s += __shfl_xor(s, 16); s += __shfl_xor(s, 32);
    const float mu = s * (1.f / 128.f); float q = 0.f;
#pragma unroll
    for (int dt = 0; dt < 8; ++dt) { const f32x4 d = o[dt] - mu; q += (d[0] * d[0] + d[1] * d[1]) + (d[2] * d[2] + d[3] * d[3]); }
    q += __shfl_xor(q, 16); q += __shfl_xor(q, 32);
    const float rstd = rsqrtf(q * (1.f / 128.f) + 1e-5f);
#pragma unroll
    for (int dt = 0; dt < 8; ++dt) { const int col = h * 128 + dt * 16 + 4 * fq; const f32x4 gg = *(const f32x4*)(gn + col); const u32x2 gw = *(const u32x2*)(GR + (size_t)row * 512 + col);
        const float g0 = bflo(gw.x), g1 = bfhi(gw.x), g2 = bflo(gw.y), g3 = bfhi(gw.y);
        const f32x4 y = (o[dt] - mu) * rstd * gg;
        u32x2 w; w.x = pk2(g0 * sigm(g0) * y[0], g1 * sigm(g1) * y[1]); w.y = pk2(g2 * sigm(g2) * y[2], g3 * sigm(g3) * y[3]);
        ST8(Rout + (size_t)row * 512 + col, w); }
}

#define RLX_AGENT __ATOMIC_RELAXED, __HIP_MEMORY_SCOPE_AGENT
#define XB_TMO      128
#define XB_XCNT(j)  (256  + 64 * (j))
#define XB_XSUB(j)  (1280 + 64 * (j))
#define XB_XGEN(j)  (2304 + 64 * (j))
#define XB_TOP      3328
#define XB_TOPGEN   3392
#define XCD_BAR_WORDS 3456
#define XB_SPIN_CAP (1u << 18)

__device__ __forceinline__ unsigned xb_ld(unsigned* p)              { return __hip_atomic_load(p, __ATOMIC_RELAXED, __HIP_MEMORY_SCOPE_AGENT); }
__device__ __forceinline__ unsigned xb_add(unsigned* p, unsigned v) { return __hip_atomic_fetch_add(p, v, __ATOMIC_RELAXED, __HIP_MEMORY_SCOPE_AGENT); }
__device__ __forceinline__ unsigned xb_xcc_id() { return (unsigned)__builtin_amdgcn_s_getreg((3 << 11) | 20) & 0xFu; }
#define XB_SPIN(cond, bar) do { unsigned _sp = 0; while (cond) { __builtin_amdgcn_s_sleep(1); \
    if ((++_sp & 255u) == 0u) { if (xb_ld(&(bar)[XB_TMO])) break; if (_sp > XB_SPIN_CAP) { atomicAdd(&(bar)[XB_TMO], 1u); break; } } } } while (0)

struct XcdBarrier {
    unsigned* bar; unsigned x;
    volatile LAS unsigned* st;
};

__device__ __forceinline__ XcdBarrier xcd_barrier_post(unsigned* bar, volatile LAS unsigned* st) {
    XcdBarrier b; b.bar = bar; b.x = xb_xcc_id(); b.st = st;
    if (threadIdx.x == 0) (void)xb_add(&bar[XB_XCNT(b.x)], 1u);
    return b;
}
__device__ __forceinline__ void xcd_barrier_complete(unsigned* bar, unsigned x, unsigned& nloc, unsigned& nx) {
    const unsigned G = gridDim.x * gridDim.y * gridDim.z;
    unsigned sum, cnt, mine, sp = 0u;
    for (;;) {
        sum = 0u; cnt = 0u; mine = 0u;
#pragma unroll
        for (unsigned j = 0; j < 16; ++j) { const unsigned c = xb_ld(&bar[XB_XCNT(j)]); sum += c; cnt += (c > 0u) ? 1u : 0u; mine = (j == x) ? c : mine; }
        if (sum == G) break;
        __builtin_amdgcn_s_sleep(1);
        if ((++sp & 255u) == 0u) { if (xb_ld(&bar[XB_TMO])) break; if (sp > XB_SPIN_CAP) { atomicAdd(&bar[XB_TMO], 1u); break; } }
    }
    nloc = mine > 0u ? mine : 1u; nx = cnt > 0u ? cnt : 1u;
}

__device__ __forceinline__ void xcd_barrier(const XcdBarrier& b) {
    asm volatile("s_waitcnt vmcnt(0)" ::: "memory");
    __syncthreads();
    if (threadIdx.x == 0) {
        unsigned* bar = b.bar;
        __builtin_amdgcn_s_waitcnt(0);
        unsigned nloc = b.st[0], nx = b.st[1];
        if (nloc == 0u) { xcd_barrier_complete(bar, b.x, nloc, nx); b.st[0] = nloc; b.st[1] = nx; }
        const unsigned old = xb_add(&bar[XB_XSUB(b.x)], 1u);
        const unsigned gen = old / nloc;
        if (old + 1u == (gen + 1u) * nloc) {
            __builtin_amdgcn_fence(__ATOMIC_RELEASE, "agent");
            asm volatile("s_waitcnt vmcnt(0)" ::: "memory");
            const unsigned og = xb_add(&bar[XB_TOP], 1u);
            const unsigned tg = og / nx;
            if (og + 1u == (tg + 1u) * nx) xb_add(&bar[XB_TOPGEN], 1u);
            else XB_SPIN(xb_ld(&bar[XB_TOPGEN]) == tg, bar);
            __builtin_amdgcn_fence(__ATOMIC_ACQUIRE, "agent");
            xb_add(&bar[XB_XGEN(b.x)], 1u);
            asm volatile("s_waitcnt vmcnt(0)" ::: "memory");
        } else {
            XB_SPIN(xb_ld(&bar[XB_XGEN(b.x)]) == gen, bar);
            __builtin_amdgcn_fence(__ATOMIC_ACQUIRE, "agent");
            asm volatile("s_waitcnt vmcnt(0)" ::: "memory");
        }
    }
    __syncthreads();
}

__global__ void __launch_bounds__(NWAVES * 64, 2) fwd_megakernel(Args args) {
    extern __shared__ __attribute__((aligned(16))) unsigned char lds_raw[];
    LAS unsigned char* lds = (LAS unsigned char*)lds_raw;
    cg::grid_group grid = cg::this_grid();
    const int tid0 = threadIdx.x, wave = __builtin_amdgcn_readfirstlane(tid0 >> 6);
    const int G = gridDim.x, gw = blockIdx.x * NWAVES + wave, NGW = G * NWAVES;
    unsigned char* ws = args.ws;
    const float* x = args.in[0]; const float* cvec = args.in[1]; const float* ctx = args.in[2]; const float* cctx = args.in[3];
    float* out = args.out; float* HC = (float*)(ws + WS_HC);
    float* MOD = (float*)(ws + WS_MOD); float* RT = (float*)(ws + WS_RT);
    unsigned char* U = ws + WS_U;
    const int lo = args.ph_lo, hi = args.ph_hi;
    int pid = 0;
    if (tid0 < 64) ((LAS unsigned*)(lds + 131072))[tid0] = 0u;
    if (blockIdx.x == 0 && lo == 0) { unsigned* bw = (unsigned*)(ws + WS_BAR); for (int i = tid0; i < XCD_BAR_WORDS; i += NWAVES * 64) __hip_atomic_store(bw + i, 0u, __ATOMIC_RELAXED, __HIP_MEMORY_SCOPE_AGENT); }
    __syncthreads();
    XcdBarrier xbar; xbar.bar = (unsigned*)(ws + WS_BAR); xbar.x = 0; xbar.st = nullptr;
#define PH_BEGIN if (pid >= lo && pid < hi) { int tid = tid0; asm volatile("" : "+v"(tid)); const int lane = tid & 63; (void)lane;
#define PH_END } if (pid >= lo && pid + 1 < hi) { if (pid == 0) { grid.sync(); xbar = xcd_barrier_post((unsigned*)(ws + WS_BAR), (volatile LAS unsigned*)(lds + 131072)); } else { for (int s_ = 0; s_ < NSYNC; ++s_) xcd_barrier(xbar); } } ++pid;

    PH_BEGIN
#ifndef OFF0
#pragma unroll 1
            for (int rep_ = 0; rep_ < REP0; ++rep_) {
    {
        LAS float* sv = (LAS float*)lds;
        LAS float* red = (LAS float*)(lds + 40960);
        for (int i = tid; i < 9 * D; i += NWAVES * 64) { const float v = (i < 8 * D) ? cvec[i] : cctx[i - 8 * D]; sv[i] = v / (1.f + expf(-v)); }
        __syncthreads();
        for (int item = blockIdx.x; item < 2 * 96; item += G) {
            const int l = item / 96, col = (item % 96) * 64 + lane;
            const float* wa = args.in[6] + (size_t)l * D * NMODC + col;
            float a[9];
#pragma unroll
            for (int b = 0; b < 9; ++b) a[b] = 0.f;
#pragma unroll 16
            for (int kk = 0; kk < 128; ++kk) { const int k = wave * 128 + kk; const float wv = wa[(size_t)k * NMODC];
#pragma unroll
                for (int b = 0; b < 9; ++b) a[b] += sv[b * D + k] * wv; }
#pragma unroll
            for (int b = 0; b < 9; ++b) red[(wave * 9 + b) * 64 + lane] = a[b];
            __syncthreads();
            for (int o = tid; o < 9 * 64; o += NWAVES * 64) { const int b = o >> 6, ln = o & 63; float s = 0.f;
#pragma unroll
                for (int w = 0; w < 8; ++w) s += red[(w * 9 + b) * 64 + ln];
                const int cc = (item % 96) * 64 + ln; MOD[((size_t)l * 9 + b) * NMODC + cc] = s + args.in[7][(size_t)l * NMODC + cc]; }
            __syncthreads();
        }
        if (blockIdx.x == G - 1) { for (int i = tid; i < 64 * 16; i += NWAVES * 64) { const int pos = i >> 4, f = i & 15; const float inv = powf(10000.f, -(float)f / 16.f); const float ang = (float)pos * inv;
            RT[2 * i] = cosf(ang); RT[2 * i + 1] = sinf(ang); } }
        __syncthreads();
        LAS float* scr = (LAS float*)(lds + wave * 16384);
        constexpr int I_IN = 16 * (INW / 32), I_BR = 8 * 32, I_O = 16 * 32, I_G = 16 * (FF / 32), I_D = (FF / 64) * 32, I_P = 2 * 4;
        constexpr int I_LAYER = I_IN + 3 * I_BR + I_O + 2 * I_G + I_D + 4 * I_P;
        for (int it = gw; it < 2 * I_LAYER; it += NGW) {
            const int l = it / I_LAYER; int r = it - l * I_LAYER; unsigned char* wl = ws + WS_W + (size_t)l * WL_STRIDE;
            if (r < I_IN) { transpose_item(args.in[8] + (size_t)l * D * INW, D, INW, (bf16*)(wl + W_IN), 0, scr, r, lane); continue; } r -= I_IN;
            if (r < I_BR) { transpose_item(args.in[15] + (size_t)l * 512 * D, 512, D, (bf16*)(wl + W_BA), 0, scr, r, lane); continue; } r -= I_BR;
            if (r < I_BR) { transpose_item(args.in[16] + (size_t)l * 512 * D, 512, D, (bf16*)(wl + W_BB), 0, scr, r, lane); continue; } r -= I_BR;
            if (r < I_BR) { transpose_item(args.in[17] + (size_t)l * 512 * D, 512, D, (bf16*)(wl + W_BC), 0, scr, r, lane); continue; } r -= I_BR;
            if (r < I_O) { transpose_item(args.in[18] + (size_t)l * D * D, D, D, (bf16*)(wl + W_O), 0, scr, r, lane); continue; } r -= I_O;
            if (r < I_G) { transpose_item(args.in[19] + (size_t)l * D * FF, D, FF, (bf16*)(wl + W_GU), 1, scr, r, lane); continue; } r -= I_G;
            if (r < I_G) { transpose_item(args.in[20] + (size_t)l * D * FF, D, FF, (bf16*)(wl + W_GU), 2, scr, r, lane); continue; } r -= I_G;
            if (r < I_D) { transpose_item(args.in[21] + (size_t)l * FF * D, FF, D, (bf16*)(wl + W_D), 0, scr, r, lane); continue; } r -= I_D;
            { const int g = r / I_P; transpose_item(args.in[13] + ((size_t)l * 4 + g) * 128 * 128, 128, 128, (bf16*)(wl + W_P) + (size_t)g * 128 * 128, 0, scr, r % I_P, lane); }
        }
        __syncthreads();
    }
            }
#endif
    PH_END

#pragma unroll 1
    for (int l = 0; l < 2; ++l) {
        const bool with_ctx = (l == 0);
        unsigned char* wl = ws + WS_W + (size_t)l * WL_STRIDE;
        const float* modl = MOD + (size_t)l * 9 * NMODC;
        const float* hl = (l == 0) ? x : out; const float* hcs = (l == 0) ? ctx : HC;
        PH_BEGIN
#ifndef OFF1
#pragma unroll 1
            for (int rep_ = 0; rep_ < REP1; ++rep_) {
            for (int rr = gw; rr < 2 * HROWS; rr += NGW) {
                const int g = rr >= HROWS ? 1 : 0, r = rr - g * HROWS;
                const float* src; int bidx;
                if (r < LROWS) { const int gr = g * LROWS + r; src = hl + (size_t)gr * D; bidx = gr >> 12; } else { const int gc = g * CROWS + (r - LROWS); src = hcs + (size_t)gc * D; bidx = 8; }
                norm_row(src, (bf16*)(ws + WS_XN) + (size_t)rr * D, args.in[4] + l * D, modl + bidx * NMODC, modl + bidx * NMODC + D, lane);
            }
            }
#endif
        PH_END
#pragma unroll 1
        for (int s = 0; s < 3; ++s) {
            PH_BEGIN
            if (s == 2) {
                const int g = 1;
                const int Mr = with_ctx ? HROWS : LROWS;
                pg8::Gemm gm{(const bf16*)(ws + WS_XN + g * XN_HALF), (const bf16*)(wl + W_O), 0, 0, Mr, D, D};
                pg8::StaticOrder S; S.init(Mr, D, G, (int)blockIdx.x);
                EpiResid E{hl, hcs, out, HC, modl + 2 * D, LROWS / 256, g * LROWS, g * CROWS};
                pg8::gemm_phase<EpiResid, pg8::StaticOrder, ALIGN_SMALL, true>(lds, gm, S, E);
            }
            if (s == 2) {
                for (int q = NGW - 1 - gw; q < (with_ctx ? HROWS : LROWS); q += NGW) {
                    const int r = q < LROWS ? q : TLAT + (q - LROWS);
                    const float* src; int bidx;
                    if (r < TLAT) { src = out + (size_t)r * D; bidx = r >> 12; } else { src = HC + (size_t)(r - TLAT) * D; bidx = 8; }
                    norm_row(src, (bf16*)(ws + WS_FX) + (size_t)r * D, args.in[5] + l * D, modl + bidx * NMODC + 3 * D, modl + bidx * NMODC + 4 * D, lane);
                }
            }
            if (s < 2) {
                const int g = s;
                pg8::Gemm gm{(const bf16*)(ws + WS_XN + g * XN_HALF), (const bf16*)(wl + W_IN), 0, (long)3584 * D, HROWS, INW, D};
                const int lo_ = (g == 1 && with_ctx) ? IP_TAIL : 0;
                pg8::InprojOrder S; S.SA.init(HROWS, 3584, 1, 0); S.SB.init(HROWS, 3072, 1, 0); S.lo = lo_; S.nA = (HROWS / 256) * 14 - lo_; S.nB = (HROWS / 256) * 12; S.G = G; S.c = (int)blockIdx.x;
                EpiInproj E{U};
                pg8::gemm_phase<EpiInproj, pg8::InprojOrder, true, true>(lds, gm, S, E);
            }
            PH_END
            if (s < 2) {
            const int g = s;
            PH_BEGIN
#ifndef OFF3
#pragma unroll 1
            for (int rep_ = 0; rep_ < REP3; ++rep_) {
            {
                constexpr int NA_K_OFF = 0, NA_V_OFF = 36864, NA_RP_OFF = 36864 + 33792;
                LAS float* rp = (LAS float*)(lds + NA_RP_OFF);
                for (int i = tid; i < 8 * 15 * 31; i += NWAVES * 64) rp[i] = args.in[9][(size_t)l * 8 * 15 * 31 + i];
                bf16* Aout = (bf16*)(ws + WS_ARP); bf16* Pout = (bf16*)(ws + WS_ARP + 34 * MiB);
                const int vcu = (G % 8 == 0) ? ((int)blockIdx.x % 8) * (G / 8) + (int)blockIdx.x / 8 : (int)blockIdx.x;
                const int nb_na = HB * 8 * 8, nb_nac = 0;
#ifndef M1_NO_NA
#pragma unroll 1
                for (int bi = vcu; bi < nb_na; bi += G) {
                    const int rg = bi & 7, h = (bi >> 3) & 7, bl = bi >> 6, R = rg * 8;
                    const int fr = lane & 15, fq = lane >> 4, cb = wave & 3, rw = R + (wave >> 2) * 4;
                    const int kstart = min(max(16 * cb - 8, 0), 32), qc = 16 * cb + fr, ws_ = min(max(qc - 8, 0), 48);
                    NaState S4[4];
                    const bf16* Qp0 = (const bf16*)(U + U_QN) + (size_t)(bl * SEQ + rw * 64 + cb * 16 + fr) * 512 + h * 64 + fq * 8;
                    __syncthreads();
                    {
                        const bf16* KN = (const bf16*)(U + U_KN) + (size_t)(LROWS + bl * CTXL) * 512 + h * 64; const bf16* VTC = (const bf16*)(U + U_VTC) + (size_t)((bl * 8 + h) * 64) * CTXL;
#pragma unroll
                        for (int i = 0; i < 4; ++i) { const int ch = tid + i * 512; const int key = ch >> 3, c = ch & 7;
                            const int rho = (key & ~31) + 16 * ((key >> 2) & 1) + 4 * ((key >> 3) & 3) + (key & 3);
                            *(LAS u32x4*)(lds + NA_K_OFF + rho * 144 + c * 16) = *(const u32x4*)(KN + (size_t)key * 512 + c * 8); }
#pragma unroll
                        for (int i = 0; i < 4; ++i) { const int ch = tid + i * 512; const int d = ch >> 5, c = ch & 31;
                            *(LAS u32x4*)(lds + NA_V_OFF + d * 528 + c * 16) = *(const u32x4*)(VTC + (size_t)d * CTXL + c * 8); }
                    }
                    __syncthreads();
                    if (with_ctx && wave < 2)
                        na_item<false>(U, Aout, rp, lds + NA_K_OFF, lds + NA_V_OFF, bl, h, LROWS + bl * CTXL + (rg * 2 + wave) * 16, 0, 0, lane);
                    EPI_FENCE();
#pragma unroll
                    for (int i = 0; i < 4; ++i) {
#pragma unroll
                        for (int dt = 0; dt < 4; ++dt) S4[i].o[dt] = (f32x4){0.f, 0.f, 0.f, 0.f};
                        S4[i].mrun = -1e30f; S4[i].l = 0.f; }
#pragma unroll
                    for (int i = 0; i < 4; ++i) {
#pragma unroll 1
                        for (int blk = 0; blk < 2; ++blk) { na_block<false>(S4[i], ld16(Qp0 + (size_t)i * 64 * 512), ld16(Qp0 + (size_t)i * 64 * 512 + 32), nullptr, nullptr, lds + NA_K_OFF + (size_t)(128 * blk + fr) * 144 + fq * 16, lds + NA_V_OFF + (size_t)fr * 528 + (128 * blk + 8 * fq) * 2, rp, 0, 0, 0, fq); EPI_FENCE(); } }
#pragma unroll 1
                    for (int kb = 0; kb < 4; ++kb) {
                        const int rowb = R - 4 + 4 * kb;
                        if (rowb + 3 < 0 || rowb > 63) continue;
                        __syncthreads();
                        {
                            const bf16* KNb = (const bf16*)(U + U_KN) + (size_t)(bl * SEQ) * 512 + h * 64; const bf16* VTb = (const bf16*)(U + U_VT) + (size_t)((bl * 8 + h) * 64) * SEQ;
#pragma unroll
                            for (int i = 0; i < 4; ++i) { const int ch = tid + i * 512; const int key = ch >> 3, c = ch & 7; const int row = min(max(rowb + (key >> 6), 0), 63);
                                *(LAS u32x4*)(lds + NA_K_OFF + key * 144 + c * 16) = *(const u32x4*)(KNb + (size_t)(row * 64 + (key & 63)) * 512 + c * 8); }
#pragma unroll
                            for (int i = 0; i < 4; ++i) { const int ch = tid + i * 512; const int d = ch >> 5, krl = (ch >> 3) & 3, c = ch & 7; const int row = min(max(rowb + krl, 0), 63);
                                *(LAS u32x4*)(lds + NA_V_OFF + d * 528 + (krl * 64 + c * 8) * 2) = *(const u32x4*)(VTb + (size_t)d * SEQ + row * 64 + c * 8); }
                        }
                        __syncthreads();
#pragma unroll
                        for (int i = 0; i < 4; ++i) { const int grow = rw + i, r0 = min(max(grow - 4, 0), 56);
                            if (rowb + 3 >= r0 && rowb <= r0 + 7) {
                                na_block_lw(S4[i], ld16(Qp0 + (size_t)i * 64 * 512), ld16(Qp0 + (size_t)i * 64 * 512 + 32), lds + NA_K_OFF, lds + NA_V_OFF, rp + h * 15 * 31, rowb, grow, r0, kstart, qc, ws_, fr, fq); EPI_FENCE(); } }
                    }
#pragma unroll
                    for (int i = 0; i < 4; ++i) { const float inv = 1.f / S4[i].l; bf16* op = Aout + (size_t)(bl * SEQ + (rw + i) * 64 + cb * 16 + fr) * 512 + h * 64 + 4 * fq;
#pragma unroll
                        for (int dt = 0; dt < 4; ++dt) { u32x2 w; w.x = pk2(S4[i].o[dt][0] * inv, S4[i].o[dt][1] * inv); w.y = pk2(S4[i].o[dt][2] * inv, S4[i].o[dt][3] * inv); ST8(op + dt * 16, w); } }
                }
#endif
                const int n_pt = (with_ctx ? HROWS : LROWS) / 16, n_con = HB * 4 * 34 * 8;
#pragma unroll 1
                for (int rpc_ = 0; rpc_ < REP_PC; ++rpc_) {
#ifndef M1_NO_POOL
                    const bf16* PWp = (const bf16*)(wl + W_P); const float* psc = args.in[14] + l * 512;
#pragma unroll 1
                    for (int rpool_ = 0; rpool_ < REP_POOL; ++rpool_) {
#pragma unroll 1
                    for (int it = gw; it < n_pt; it += NGW) pool_item<3>(U, PWp, psc, Pout, it * 16, lane);
                    EPI_FENCE();
#pragma unroll 1
                    for (int it = (gw + NGW / 2) % NGW; it < n_pt; it += NGW) pool_item<2>(U, PWp, psc, Pout, it * 16, lane);
                    EPI_FENCE();
#pragma unroll 1
                    for (int it = (gw + NGW / 4) % NGW; it < n_pt; it += NGW) pool_item<1>(U, PWp, psc, Pout, it * 16, lane);
                    EPI_FENCE();
#pragma unroll 1
                    for (int it = (gw + 3 * NGW / 4) % NGW; it < n_pt; it += NGW) pool_item<0>(U, PWp, psc, Pout, it * 16, lane);
                    EPI_FENCE();
                    }
#endif
#ifndef M1_NO_CON
#pragma unroll 1
                    for (int bi = blockIdx.x; bi < HB * 4 * 34; bi += G) {
                        const int ch = bi % 34, bh = bi / 34, h = bh & 3, bl = bh >> 2; const bool ic = ch < 2; const int C = ic ? ch : ch - 2;
                        { const int row0 = (ic ? LROWS + bl * CTXL : bl * SEQ) + C * 128 + ((wave >> 1) & 1) * 64;
                            rope_item(U, RT, lg2_of_logit(args.in[10][l * 4 + h]), lg2_of_logit(args.in[11][l * 4 + h]), row0, h, wave & 1, wave >> 2, lane); }
                        asm volatile("s_waitcnt vmcnt(0)" ::: "memory");
                        __syncthreads();
                        contrib_item(U, (float*)(ws + WS_ST), bl, h, ic, C, wave, lane);
                    }
#endif
                }
                __syncthreads();
            }
            }
#endif
            PH_END
            PH_BEGIN
#ifndef OFF4
#pragma unroll 1
            for (int rep_ = 0; rep_ < REP4; ++rep_) {
            {
                const float* STp = (const float*)(ws + WS_ST); bf16* PV = (bf16*)(ws + WS_PREV);
                for (int idx = blockIdx.x * (NWAVES * 64) + tid; idx < 16 * 2 * 8192; idx += G * NWAVES * 64) {
                    const int e = idx & 8191, sd = idx >> 13, dir = sd & 1, h = (sd >> 1) & 3;
                    const float l2 = lg2_of_logit(dir == 0 ? args.in[10][l * 4 + h] : args.in[11][l * 4 + h]);
                    const float gC = exp2f(l2 * 128.f);
                    float s = 0.f; const size_t base = (size_t)sd * 34 * 8192 + e;
float cv[34];
#pragma unroll
                    for (int stp = 0; stp < 34; ++stp) cv[stp] = STp[base + (size_t)stp * 8192];
#pragma unroll
                    for (int stp = 0; stp < 34; ++stp) { PV[base + (size_t)stp * 8192] = bf1(s); s = s * gC + cv[stp]; }
                }
            }
            }
#endif
            PH_END
            PH_BEGIN
#ifndef OFF5
#pragma unroll 1
            for (int rep_ = 0; rep_ < REP5; ++rep_) {
            {
                bf16* Rout = (bf16*)(ws + WS_ARP + 17 * MiB);
                const int nch = with_ctx ? 34 : 32;
                const bf16* PREV = (const bf16*)(ws + WS_PREV);
                for (int bi = blockIdx.x; bi < 16 * nch; bi += G) {
                    int ch = bi % nch; const int bh = bi / nch; const int h = bh & 3, bl = bh >> 2;
                    bool ic = false; if (with_ctx) { ic = ch < 2; ch = ic ? ch : ch - 2; }
                    const int n = ic ? CTXL : SEQ; const int rowbase = ic ? (LROWS + bl * CTXL) : bl * SEQ;
                    const int stepf = ic ? ch : 2 + ch, stepb = ic ? 1 - ch : 2 + 31 - ch;
                    const bf16* KR = (const bf16*)(U + U_KR) + (size_t)(rowbase + ch * 128) * 256 + h * 64;
                    const bf16* VTR = (const bf16*)(U + (ic ? U_VTRC : U_VTR)) + (size_t)((bl * 4 + h) * 128) * n + ch * 128;
                    const bf16* Pf = PREV + ((size_t)(((bl * 4 + h) * 2 + 0) * 34 + stepf)) * 8192; const bf16* Pb = PREV + ((size_t)(((bl * 4 + h) * 2 + 1) * 34 + stepb)) * 8192;
                    __syncthreads();
#pragma unroll
                    for (int i = 0; i < 2; ++i) { const int cx = tid + i * 512; const int key = cx >> 3, c = cx & 7;
                        const int rho = (key & ~31) + 16 * ((key >> 2) & 1) + 4 * ((key >> 3) & 3) + (key & 3);
                        *(LAS u32x4*)(lds + RO_K + rho * 144 + c * 16) = *(const u32x4*)(KR + (size_t)key * 256 + c * 8);
                        *(LAS u32x4*)(lds + RO_PF + key * 144 + c * 16) = *(const u32x4*)(Pf + key * 64 + c * 8);
                        *(LAS u32x4*)(lds + RO_PB + key * 144 + c * 16) = *(const u32x4*)(Pb + key * 64 + c * 8); }
#pragma unroll
                    for (int i = 0; i < 4; ++i) { const int cx = tid + i * 512; const int dv = cx >> 4, c = cx & 15;
                        *(LAS u32x4*)(lds + RO_V + dv * 272 + c * 16) = *(const u32x4*)(VTR + (size_t)dv * n + c * 8); }
                    __syncthreads();
                    const float l2f = lg2_of_logit(args.in[10][l * 4 + h]), l2b = lg2_of_logit(args.in[11][l * 4 + h]);
                    retout_item(U, lds, Rout, args.in[12] + l * 512, l2f, l2b, bl, h, ic, ch, wave, lane);
                }
                __syncthreads();
            }
            }
#endif
            PH_END
            PH_BEGIN
#ifndef OFF6
#pragma unroll 1
            for (int rep_ = 0; rep_ < REP6; ++rep_) {
            {
                const int Mr = with_ctx ? HROWS : LROWS;
                pg8::Gemm gm{(const bf16*)(ws + WS_ARP), (const bf16*)(wl + W_BA), (long)(17 * MiB / 2), (long)(1 * MiB / 2), Mr, D, 512};
                pg8::ChainOrder S; S.S.init(Mr, D, G, (int)blockIdx.x);
                EpiMerge E{(const bf16*)(U + U_G), (bf16*)(ws + WS_XN + g * XN_HALF)};
                pg8::gemm_phase<EpiMerge, pg8::ChainOrder, ALIGN_SMALL, true>(lds, gm, S, E);
                if (g == 0 && with_ctx && (int)blockIdx.x >= 16) {
                    pg8::Gemm gi_{(const bf16*)(ws + WS_XN + XN_HALF), (const bf16*)(wl + W_IN), 0, (long)3584 * D, HROWS, INW, D};
                    pg8::InprojOrder SI; SI.SA.init(HROWS, 3584, 1, 0); SI.SB.init(HROWS, 3072, 1, 0); SI.lo = 0; SI.nA = IP_TAIL; SI.nB = 0; SI.G = G - 16; SI.c = (int)blockIdx.x - 16;
                    EpiInproj EI{U};
                    pg8::gemm_phase<EpiInproj, pg8::InprojOrder, true, true>(lds, gi_, SI, EI);
                }
                if (g == 1) {
                    const int skip = with_ctx ? 16 : 0;
                    if ((int)blockIdx.x >= skip) {
                        pg8::Gemm gw_{(const bf16*)(ws + WS_XN), (const bf16*)(wl + W_O), 0, 0, Mr, D, D};
                        pg8::StaticOrder SW; SW.init(Mr, D, G - skip, (int)blockIdx.x - skip);
                        EpiResid EW{hl, hcs, out, HC, modl + 2 * D, LROWS / 256, 0, 0};
                        pg8::gemm_phase<EpiResid, pg8::StaticOrder, ALIGN_SMALL, true>(lds, gw_, SW, EW);
                    }
                }
            }
            }
#endif
            PH_END
            }
        }
        const int Mf = with_ctx ? TROWS : TLAT;
        PH_BEGIN
#ifndef OFF8
#pragma unroll 1
            for (int rep_ = 0; rep_ < REP8; ++rep_) {
        for (int q = gw; q < (with_ctx ? HROWS : LROWS); q += NGW) {
            const int r = q < LROWS ? LROWS + q : TLAT + CROWS + (q - LROWS);
            const float* src; int bidx;
            if (r < TLAT) { src = out + (size_t)r * D; bidx = r >> 12; } else { src = HC + (size_t)(r - TLAT) * D; bidx = 8; }
            norm_row(src, (bf16*)(ws + WS_FX) + (size_t)r * D, args.in[5] + l * D, modl + bidx * NMODC + 3 * D, modl + bidx * NMODC + 4 * D, lane);
        }
            }
#endif
        PH_END
        PH_BEGIN
#ifndef OFF9
#pragma unroll 1
            for (int rep_ = 0; rep_ < REP9; ++rep_) {
        {
            pg8::Gemm gm{(const bf16*)(ws + WS_FX), (const bf16*)(wl + W_GU), 0, 0, Mf, 2 * FF, D};
            pg8::StaticOrder S; S.init(Mf, 2 * FF, G, (int)blockIdx.x);
            EpiFfn1 E{(bf16*)(ws + WS_HD)};
            pg8::gemm_phase<EpiFfn1, pg8::StaticOrder, true, true>(lds, gm, S, E);
        }
            }
#endif
        PH_END
        PH_BEGIN
#ifndef OFF10
#pragma unroll 1
            for (int rep_ = 0; rep_ < REP10; ++rep_) {
        {
            pg8::Gemm gm{(const bf16*)(ws + WS_HD), (const bf16*)(wl + W_D), 0, 0, Mf, D, FF};
            pg8::StaticOrder S; S.init(Mf, D, G, (int)blockIdx.x);
            EpiResid E{out, HC, out, HC, modl + 5 * D, TLAT / 256, 0, 0};
            pg8::gemm_phase<EpiResid, pg8::StaticOrder, ALIGN_SMALL, true>(lds, gm, S, E);
        }
            }
#endif
        PH_END
    }
    PH_BEGIN
#ifndef OFF11
#pragma unroll 1
            for (int rep_ = 0; rep_ < REP11; ++rep_) {
    for (int r = gw; r < TLAT; r += NGW) {
        float* p = out + (size_t)r * D; f32x4 v[4]; float ss = 0.f;
#pragma unroll
        for (int j = 0; j < 4; ++j) { v[j] = *(const f32x4*)(p + 4 * lane + 256 * j); ss += (v[j][0] * v[j][0] + v[j][1] * v[j][1]) + (v[j][2] * v[j][2] + v[j][3] * v[j][3]); }
        const float rstd = rsqrtf(wave_sum(ss) * (1.f / D) + 1e-6f);
#pragma unroll
        for (int j = 0; j < 4; ++j) { const int c = 4 * lane + 256 * j; *(f32x4*)(p + c) = v[j] * rstd * *(const f32x4*)(args.in[22] + c); }
    }
            }
#endif
    PH_END
#undef PH_BEGIN
#undef PH_END
}
constexpr int N_PHASES = 1 + 2 * (1 + 3 + 2 * 4 + 3) + 1;

extern "C" void kernel_launch(void* const* d_in, const int* in_sizes, int n_in, void* d_out, int out_size, void* d_ws, size_t ws_size, hipStream_t stream) {
    static int grid = 0;
    if (grid == 0) {
        if (n_in != 23 || in_sizes[0] != TLAT * D || out_size != TLAT * D || ws_size < WS_END) { fprintf(stderr, "kernel_launch: unexpected shapes / workspace (n_in %d, ws %zu)\n", n_in, ws_size); grid = -1; return; }
        int dev = 0, cus = 0, per_cu = 0;
        if (hipGetDevice(&dev) != hipSuccess || hipDeviceGetAttribute(&cus, hipDeviceAttributeMultiprocessorCount, dev) != hipSuccess) { grid = -1; return; }
        if (hipFuncSetAttribute((const void*)fwd_megakernel, hipFuncAttributeMaxDynamicSharedMemorySize, LDS_BYTES) != hipSuccess) { fprintf(stderr, "kernel_launch: hipFuncSetAttribute failed\n"); grid = -1; return; }
        if (hipOccupancyMaxActiveBlocksPerMultiprocessor(&per_cu, (const void*)fwd_megakernel, NWAVES * 64, LDS_BYTES) != hipSuccess || per_cu < 1) { fprintf(stderr, "kernel_launch: occupancy query says %d\n", per_cu); per_cu = 1; }
        (void)hipGetLastError();
        grid = cus * 1;
    }
    if (grid < 0) return;
    Args a{};
    for (int i = 0; i < 23; ++i) a.in[i] = (const float*)d_in[i];
    a.out = (float*)d_out; a.ws = (unsigned char*)d_ws;
#if MK_PER_PHASE
    for (int p = 0; p < N_PHASES; ++p) { a.ph_lo = p; a.ph_hi = p + 1; void* kargs[] = {&a};
        hipError_t e = hipLaunchCooperativeKernel((const void*)fwd_megakernel, dim3(grid), dim3(NWAVES * 64), kargs, LDS_BYTES, stream);
        if (e != hipSuccess) { fprintf(stderr, "launch %d failed: %s\n", p, hipGetErrorString(e)); break; } }
#else
    a.ph_lo = 0; a.ph_hi = N_PHASES;
    void* kargs[] = {&a};
    hipError_t e = hipLaunchCooperativeKernel((const void*)fwd_megakernel, dim3(grid), dim3(NWAVES * 64), kargs, LDS_BYTES, stream);
    if (e != hipSuccess) fprintf(stderr, "cooperative launch failed: %s (grid %d)\n", hipGetErrorString(e), grid);
#endif
}
```

```cpp
#include <hip/hip_runtime.h>
#include <hip/hip_cooperative_groups.h>
#include <cstdio>
#include <cstdint>
namespace cg = cooperative_groups;

#ifndef REP0
#define REP0 1
#endif
#ifndef REP1
#define REP1 1
#endif
#ifndef REP2
#define REP2 1
#endif
#ifndef REP3
#define REP3 1
#endif
#ifndef REP4
#define REP4 1
#endif
#ifndef REP5
#define REP5 1
#endif
#ifndef REP6
#define REP6 1
#endif
#ifndef REP7
#define REP7 1
#endif
#ifndef REP8
#define REP8 1
#endif
#ifndef REP9
#define REP9 1
#endif
#ifndef REP10
#define REP10 1
#endif
#ifndef REP11
#define REP11 1
#endif
#ifndef REP12
#define REP12 1
#endif
#ifndef REP_POOL
#define REP_POOL 1
#endif
#ifndef REP_CON
#define REP_CON 1
#endif
#ifndef REP_NA
#define REP_NA 1
#endif
#ifndef REP_PC
#define REP_PC 1
#endif
#ifndef NSYNC
#define NSYNC 1
#endif
#ifndef MK_PER_PHASE
#define MK_PER_PHASE 0
#endif

#ifndef PG8_WGM
#define PG8_WGM 8
#endif
namespace pg8 {
#define PG8_LAS __attribute__((address_space(3)))
typedef unsigned short bf16_t;
typedef short bf16x8 __attribute__((ext_vector_type(8)));
typedef float f32x4 __attribute__((ext_vector_type(4)));
typedef unsigned u32x4 __attribute__((ext_vector_type(4)));
constexpr int BM = 256, BK = 64, HALF = 128, HTB = HALF * BK * 2  , STAGE_BYTES = 8 * HTB, NXCD = 8, WGM = PG8_WGM;

__host__ __device__ __forceinline__ int lds_byte(int r, int c) { const int st = (r >> 4) * 2 + (c >> 5), rr = r & 15, cc = c & 31, ob = rr * 64 + cc * 2; return st * 1024 + (ob ^ (((ob >> 9) & 1) << 5)); }
__host__ __device__ __forceinline__ void stage_rc(int b, int& R, int& C) { const int st = b / 1024, sb = b % 1024, swz = sb ^ (((sb >> 9) & 1) << 5); R = (st >> 1) * 16 + swz / 64; C = (st & 1) * 32 + (swz % 64) / 2; }
__host__ __device__ __forceinline__ int perm32(int rho) { const int n = rho >> 4, i = rho & 15; return 8 * (i >> 2) + 4 * n + (i & 3); }

struct Unit { int pm, pn, sub; };
struct Gemm { const bf16_t* A; const bf16_t* Bt; long sa, sb; int M, N, K; };
__device__ __forceinline__ const bf16_t* selA(const Gemm& g, int s) { return g.A + (long)s * g.sa; }
__device__ __forceinline__ const bf16_t* selB(const Gemm& g, int s) { return g.Bt + (long)s * g.sb; }

struct StaticOrder {
    int nM, nN, nwg, G, c;
    __host__ __device__ __forceinline__ void init(int M, int N, int G_, int c_) { nM = M / BM; nN = N / BM; nwg = nM * nN; G = G_; c = c_; }
    __host__ __device__ __forceinline__ void map(int L, Unit& u) const {
        int wgid = L; { const int q = nwg / NXCD, r = nwg % NXCD, xcd = wgid % NXCD, off = wgid / NXCD; wgid = (xcd < r ? xcd * (q + 1) : r * (q + 1) + (xcd - r) * q) + off; }
        const int nig = WGM * nN, gid = wgid / nig, fm = gid * WGM, gsz = (nM - fm) < WGM ? (nM - fm) : WGM;
        u.pm = fm + ((wgid % nig) % gsz); u.pn = (wgid % nig) / gsz; u.sub = 0;
    }
    __host__ __device__ __forceinline__ bool next(int i, Unit& u) const {
        const long L = (long)i * G + c; if (L >= nwg) return false;
        map((int)L, u); return true;
    }
    __device__ __forceinline__ void a_ready(const Unit&) const {}
    __device__ __forceinline__ void done(const Unit&) const {}
};
struct InprojOrder {
    StaticOrder SA, SB; int lo, nA, nB, G, c;
    __device__ __forceinline__ bool next(int i, Unit& u) const {
        const int L = i * G + c;
        if (L < nA) { SA.map(lo + L, u); u.sub = 0; return true; }
        if (L - nA < nB) { SB.map(L - nA, u); u.sub = 1; return true; }
        return false;
    }
    __device__ __forceinline__ void a_ready(const Unit&) const {}
    __device__ __forceinline__ void done(const Unit&) const {}
};
struct ChainOrder {
    StaticOrder S;
    __device__ __forceinline__ bool next(int i, Unit& u) const { const int q = i / 3; if (!S.next(q, u)) return false; u.sub = i - 3 * q; return true; }
    __device__ __forceinline__ void a_ready(const Unit&) const {}
    __device__ __forceinline__ void done(const Unit&) const {}
};
__device__ __forceinline__ unsigned cvt_pk_bf16(float lo, float hi) { unsigned r; asm volatile("v_cvt_pk_bf16_f32 %0, %1, %2" : "=v"(r) : "v"(lo), "v"(hi)); return r; }

template <class Epi, class Sched, bool ALIGN_EPI = false, bool SP2 = false>
__device__ __forceinline__ void gemm_phase(PG8_LAS unsigned char* lds, const Gemm g, const Sched& S, const Epi& E) {
    int tid_raw = threadIdx.x; asm volatile("" : "+v"(tid_raw)); const int tid = tid_raw, wid = __builtin_amdgcn_readfirstlane(tid >> 6), lane = tid & 63, wr = wid >> 2, wc = wid & 3, fr = lane & 15, fq = lane >> 4;
    const int K = g.K, nt = K / BK;
    unsigned voffA[2], voffB[2];
#pragma unroll
    for (int i = 0; i < 2; ++i) { int R, C; stage_rc(tid * 16 + i * 8192, R, C); const int Rb = Epi::PERM ? ((R & ~31) + perm32(R & 31)) : R;
        voffA[i] = (unsigned)(R * K + C) * 2u; voffB[i] = (unsigned)(Rb * K + C) * 2u; }
    const size_t kstep = (size_t)(BK * 2);
    const size_t hstep = (size_t)HALF * K * 2;
    const size_t tstep = 2 * hstep;
    const unsigned ldsw = (unsigned)wid * 1024u;
    const int aoff = lds_byte(wr * 64 + fr, fq * 8), boff = lds_byte(wc * 32 + fr, fq * 8);
#define PG8_SA(b, h) (((b) * 2 + (h)) * HTB)
#define PG8_SB(b, h) ((4 + (b) * 2 + (h)) * HTB)
#define PG8_STAGE(bufoff, gbase, voff) do { _Pragma("unroll") for (int _i = 0; _i < 2; ++_i) \
        __builtin_amdgcn_global_load_lds((const unsigned*)((const char*)(gbase) + (voff)[_i]), (PG8_LAS unsigned*)(lds + (bufoff) + ldsw + _i * 8192), 16, 0, 0); } while (0)
#define PG8_LDA(dst, b, h) do { _Pragma("unroll") for (int m = 0; m < 4; ++m) _Pragma("unroll") for (int k = 0; k < 2; ++k) dst[m][k] = *(const PG8_LAS bf16x8*)(lds + PG8_SA(b, h) + aoff + m * 2048 + k * 1024); } while (0)
#define PG8_LDB(dst, b, h) do { _Pragma("unroll") for (int n = 0; n < 2; ++n) _Pragma("unroll") for (int k = 0; k < 2; ++k) dst[n][k] = *(const PG8_LAS bf16x8*)(lds + PG8_SB(b, h) + boff + n * 2048 + k * 1024); } while (0)
#define PG8_MMA(ai, bj, At, Bt) do { __builtin_amdgcn_s_setprio(1); _Pragma("unroll") for (int m = 0; m < 4; ++m) _Pragma("unroll") for (int n = 0; n < 2; ++n) _Pragma("unroll") for (int k = 0; k < 2; ++k) \
        acc[ai][bj][m][n] = __builtin_amdgcn_mfma_f32_16x16x32_bf16(Bt[n][k], At[m][k], acc[ai][bj][m][n], 0, 0, 0); __builtin_amdgcn_s_setprio(0); } while (0)
#define PG8_WAIT_V(n) asm volatile("s_waitcnt vmcnt(" #n ")" ::: "memory")
#define PG8_WAIT_L(n) asm volatile("s_waitcnt lgkmcnt(" #n ")" ::: "memory")
#define PG8_BAR __builtin_amdgcn_s_barrier()
#define PG8_SCHED __builtin_amdgcn_sched_barrier(0)
    Unit cur, nxt; int ui = 0;
    if (!S.next(0, cur)) return;
    f32x4 acc[2][2][4][2];
#pragma unroll
    for (int a = 0; a < 2; ++a)
#pragma unroll
        for (int b = 0; b < 2; ++b)
#pragma unroll
            for (int m = 0; m < 4; ++m)
#pragma unroll
                for (int n = 0; n < 2; ++n) acc[a][b][m][n] = (f32x4){0.f, 0.f, 0.f, 0.f};
    bf16x8 At[4][2], B0[2][2], B1[2][2];
    const char* cA = (const char*)selA(g, cur.sub) + (size_t)cur.pm * tstep; const char* cB = (const char*)selB(g, cur.sub) + (size_t)cur.pn * tstep;
    S.a_ready(cur);
    if constexpr (SP2) {
        PG8_STAGE(PG8_SB(0, 0), cB, voffB); PG8_STAGE(PG8_SB(0, 1), cB + hstep, voffB); PG8_STAGE(PG8_SA(0, 0), cA, voffA); PG8_STAGE(PG8_SA(0, 1), cA + hstep, voffA);
        if (wr == 1) PG8_BAR;
        PG8_WAIT_V(2); PG8_BAR;
        PG8_STAGE(PG8_SB(1, 0), cB + kstep, voffB); PG8_STAGE(PG8_SA(1, 0), cA + kstep, voffA); PG8_STAGE(PG8_SB(1, 1), cB + hstep + kstep, voffB);
        PG8_WAIT_V(6); PG8_BAR;
    } else {
        PG8_STAGE(PG8_SB(0, 0), cB, voffB); PG8_STAGE(PG8_SA(0, 0), cA, voffA); PG8_STAGE(PG8_SB(0, 1), cB + hstep, voffB); PG8_STAGE(PG8_SA(0, 1), cA + hstep, voffA);
        if (wr == 1) PG8_BAR;
        PG8_WAIT_V(4); PG8_BAR;
        PG8_STAGE(PG8_SB(1, 0), cB + kstep, voffB); PG8_STAGE(PG8_SA(1, 0), cA + kstep, voffA); PG8_STAGE(PG8_SB(1, 1), cB + hstep + kstep, voffB);
        PG8_WAIT_V(6); PG8_BAR;
    }
    for (;;) {
        const bool has_next = S.next(ui + 1, nxt);
        const char* nA = has_next ? (const char*)selA(g, nxt.sub) + (size_t)nxt.pm * tstep : cA; const char* nB = has_next ? (const char*)selB(g, nxt.sub) + (size_t)nxt.pn * tstep : cB;
        for (int t = 0; t < nt; t += 2) {
            const bool last = (t == nt - 2);
            const char* a1 = cA + (size_t)(t + 1) * kstep;
            const char* a2 = last ? nA : cA + (size_t)(t + 2) * kstep; const char* b2 = last ? nB : cB + (size_t)(t + 2) * kstep;
            const char* a3 = a2 + kstep; const char* b3 = b2 + kstep;
            if (last && has_next) S.a_ready(nxt);
            if constexpr (SP2) {
            PG8_LDB(B0, 0, 0); PG8_LDB(B1, 0, 1); PG8_SCHED; PG8_LDA(At, 0, 0); PG8_STAGE(PG8_SA(1, 1), a1 + hstep, voffA);
            PG8_WAIT_V(8); PG8_WAIT_L(0); PG8_BAR; PG8_MMA(0, 0, At, B0); PG8_MMA(0, 1, At, B1); PG8_BAR; PG8_SCHED;
            PG8_LDA(At, 0, 1); PG8_STAGE(PG8_SB(0, 0), b2, voffB); PG8_STAGE(PG8_SB(0, 1), b2 + hstep, voffB); PG8_STAGE(PG8_SA(0, 0), a2, voffA);
            PG8_WAIT_V(8); PG8_WAIT_L(0); PG8_BAR; PG8_MMA(1, 0, At, B0); PG8_MMA(1, 1, At, B1); PG8_BAR; PG8_SCHED;
            PG8_LDB(B0, 1, 0); PG8_LDB(B1, 1, 1); PG8_SCHED; PG8_LDA(At, 1, 0); PG8_STAGE(PG8_SA(0, 1), a2 + hstep, voffA);
            PG8_WAIT_V(8); PG8_WAIT_L(0); PG8_BAR; PG8_MMA(0, 0, At, B0); PG8_MMA(0, 1, At, B1); PG8_BAR; PG8_SCHED;
            PG8_LDA(At, 1, 1); PG8_STAGE(PG8_SB(1, 0), b3, voffB); PG8_STAGE(PG8_SB(1, 1), b3 + hstep, voffB); PG8_STAGE(PG8_SA(1, 0), a3, voffA);
            PG8_WAIT_V(8); PG8_WAIT_L(0); PG8_BAR; PG8_MMA(1, 0, At, B0); PG8_MMA(1, 1, At, B1); PG8_BAR; PG8_SCHED;
            } else {
            PG8_LDB(B0, 0, 0); PG8_SCHED; PG8_LDA(At, 0, 0); PG8_STAGE(PG8_SA(1, 1), a1 + hstep, voffA);
            PG8_WAIT_L(8); PG8_BAR; PG8_WAIT_L(0); PG8_MMA(0, 0, At, B0); PG8_BAR; PG8_SCHED;
            PG8_LDB(B1, 0, 1); PG8_STAGE(PG8_SB(0, 0), b2, voffB);
            PG8_BAR; PG8_WAIT_L(0); PG8_MMA(0, 1, At, B1); PG8_BAR;
            PG8_LDA(At, 0, 1); PG8_STAGE(PG8_SA(0, 0), a2, voffA);
            PG8_BAR; PG8_WAIT_L(0); PG8_MMA(1, 0, At, B0); PG8_BAR; PG8_SCHED;
            PG8_STAGE(PG8_SB(0, 1), b2 + hstep, voffB);
            PG8_WAIT_V(6); PG8_BAR; PG8_MMA(1, 1, At, B1); PG8_BAR;
            PG8_LDB(B0, 1, 0); PG8_SCHED; PG8_LDA(At, 1, 0); PG8_STAGE(PG8_SA(0, 1), a2 + hstep, voffA);
            PG8_WAIT_L(8); PG8_BAR; PG8_WAIT_L(0); PG8_MMA(0, 0, At, B0); PG8_BAR; PG8_SCHED;
            PG8_LDB(B1, 1, 1); PG8_STAGE(PG8_SB(1, 0), b3, voffB);
            PG8_BAR; PG8_WAIT_L(0); PG8_MMA(0, 1, At, B1); PG8_BAR;
            PG8_LDA(At, 1, 1); PG8_STAGE(PG8_SA(1, 0), a3, voffA);
            PG8_BAR; PG8_WAIT_L(0); PG8_MMA(1, 0, At, B0); PG8_BAR; PG8_SCHED;
            PG8_STAGE(PG8_SB(1, 1), b3 + hstep, voffB);
            PG8_WAIT_V(6); PG8_BAR; PG8_MMA(1, 1, At, B1); PG8_BAR;
            }
        }
        if constexpr (ALIGN_EPI) { if (wr == 0) PG8_BAR; }
        if constexpr (!Epi::AFTER_DRAIN) { E(acc, cur, wr, wc, fr, fq); S.done(cur); }
        if (!has_next) break;
        if (!(Epi::CHAIN && nxt.sub != 0))
#pragma unroll
        for (int a = 0; a < 2; ++a)
#pragma unroll
            for (int b = 0; b < 2; ++b)
#pragma unroll
                for (int m = 0; m < 4; ++m)
#pragma unroll
                    for (int n = 0; n < 2; ++n) acc[a][b][m][n] = (f32x4){0.f, 0.f, 0.f, 0.f};
        cur = nxt; cA = nA; cB = nB; ++ui;
        if constexpr (ALIGN_EPI) { if (wr == 1) PG8_BAR; }
    }
    PG8_WAIT_V(0);
    if constexpr (!ALIGN_EPI) { if (wr == 0) PG8_BAR; }
    PG8_BAR;
    if constexpr (Epi::AFTER_DRAIN) { E.fused(acc, cur, wr, wc, fr, fq, lds, wid, lane); S.done(cur); }
#undef PG8_SA
#undef PG8_SB
#undef PG8_STAGE
#undef PG8_LDA
#undef PG8_LDB
#undef PG8_MMA
#undef PG8_WAIT_V
#undef PG8_WAIT_L
#undef PG8_BAR
#undef PG8_SCHED
}

}

constexpr int NWAVES = 8;
constexpr int D = 1024, NBATCH = 8, SEQ = 4096, CTXL = 256, INW = 6656, FF = 2816;
constexpr int HB = 4;
constexpr int LROWS = HB * SEQ, CROWS = HB * CTXL, HROWS = LROWS + CROWS;
constexpr int TLAT = NBATCH * SEQ, TCTX = NBATCH * CTXL, TROWS = TLAT + TCTX;
constexpr int NMODC = 6 * D;

constexpr size_t MiB = 1u << 20;
constexpr size_t WS_BAR = 16 * 1024;
constexpr size_t WS_MOD = 64 * 1024;
constexpr size_t WS_RT = 512 * 1024;
constexpr size_t WS_W = 1 * MiB, WL_STRIDE = 35 * MiB;
constexpr size_t W_IN = 0, W_BA = 13 * MiB, W_BB = 14 * MiB, W_BC = 15 * MiB, W_O = 16 * MiB, W_GU = 18 * MiB, W_D = 29 * MiB, W_P = 34 * MiB + 512 * 1024;
constexpr size_t WS_HC = 71 * MiB;
constexpr size_t WS_XN = 79 * MiB;
constexpr size_t WS_U = 147 * MiB;
constexpr size_t U_QN = 0, U_KN = 17 * MiB, U_VT = 34 * MiB, U_VTC = 50 * MiB, U_QR = 51 * MiB, U_KR = 59 * MiB + 512 * 1024, U_KTF = 68 * MiB, U_KTFC = 76 * MiB,
                 U_KTB = 76 * MiB + 512 * 1024, U_KTBC = 84 * MiB + 512 * 1024, U_VTR = 85 * MiB, U_VTRC = 101 * MiB, U_GR = 102 * MiB, U_UP = 119 * MiB, U_G = 136 * MiB;
constexpr size_t WS_ARP = 385 * MiB;
constexpr size_t WS_ST = 436 * MiB, WS_PREV = 470 * MiB, WS_END = 487 * MiB;
constexpr size_t XN_HALF = 34 * MiB;
constexpr size_t WS_FX = WS_ARP;
constexpr size_t WS_HD = WS_U;

constexpr int IP_TAIL = 480;
constexpr int LDS_BYTES = 131072 + 1024;

#define LAS __attribute__((address_space(3)))
typedef unsigned short bf16;
typedef short bf16x8 __attribute__((ext_vector_type(8)));
typedef float f32x4 __attribute__((ext_vector_type(4)));
typedef float f32x2 __attribute__((ext_vector_type(2)));
typedef unsigned u32x4 __attribute__((ext_vector_type(4)));
typedef unsigned u32x2 __attribute__((ext_vector_type(2)));
#ifndef ALIGN_SMALL
#define ALIGN_SMALL true
#endif
#ifndef WT8
#define WT8 0
#endif
#if WT8
#define ST8(p, w) __hip_atomic_store((unsigned long long*)(p), __builtin_bit_cast(unsigned long long, (w)), __ATOMIC_RELAXED, __HIP_MEMORY_SCOPE_AGENT)
#else
#define ST8(p, w) (*(u32x2*)(p) = (w))
#endif
#define MMA16(a, b, c) __builtin_amdgcn_mfma_f32_16x16x32_bf16(a, b, c, 0, 0, 0)
#define LOG2E 1.4426950408889634f

__device__ __forceinline__ unsigned pk2(float lo, float hi) { return pg8::cvt_pk_bf16(lo, hi); }
__device__ __forceinline__ float bflo(unsigned w) { return __uint_as_float(w << 16); }
__device__ __forceinline__ float bfhi(unsigned w) { return __uint_as_float(w & 0xffff0000u); }
__device__ __forceinline__ bf16x8 ld16(const bf16* p) { return *(const bf16x8*)p; }
__device__ __forceinline__ unsigned short bf1(float v) { return (unsigned short)(pk2(v, 0.f) & 0xffffu); }
__device__ __forceinline__ float wave_sum(float v) {
#pragma unroll
    for (int o = 1; o < 64; o <<= 1) v += __shfl_xor(v, o);
    return v;
}
__device__ __forceinline__ float lg2_of_logit(float logit) { return -log1pf(expf(-logit)) * LOG2E; }
__device__ __forceinline__ float enx(float g) { return __builtin_amdgcn_exp2f(__builtin_amdgcn_fmed3f(g, -30.f, 30.f) * -LOG2E); }
__device__ __forceinline__ float sigm(float g) { return __builtin_amdgcn_rcpf(1.f + enx(g)); }
__device__ __forceinline__ float sigratio(float a, float b) { return (1.f + enx(b)) * __builtin_amdgcn_rcpf(1.f + enx(a)); }

__device__ __forceinline__ float dppx1(float v) { return __builtin_bit_cast(float, __builtin_amdgcn_mov_dpp(__builtin_bit_cast(int, v), 0xB1, 0xF, 0xF, true)); }
__device__ __forceinline__ float dppx2(float v) { return __builtin_bit_cast(float, __builtin_amdgcn_mov_dpp(__builtin_bit_cast(int, v), 0x4E, 0xF, 0xF, true)); }
__device__ __forceinline__ f32x4 quad_transpose(f32x4 v, bool b0, bool b1) {
    const float r0 = dppx1(b0 ? v[0] : v[1]), r1 = dppx1(b0 ? v[2] : v[3]);
    const float x0 = b0 ? r0 : v[0], x1 = b0 ? v[1] : r0, x2 = b0 ? r1 : v[2], x3 = b0 ? v[3] : r1;
    const float q0 = dppx2(b1 ? x0 : x2), q1 = dppx2(b1 ? x1 : x3);
    f32x4 w; w[0] = b1 ? q0 : x0; w[1] = b1 ? q1 : x1; w[2] = b1 ? x2 : q0; w[3] = b1 ? x3 : q1; return w;
}

struct EpiInproj {
    static constexpr bool PERM = false, AFTER_DRAIN = false, CHAIN = false;
    unsigned char* U;
#define EPI_FENCE() asm volatile("" ::: "memory")
    __device__ __forceinline__ void operator()(f32x4 (&acc)[2][2][4][2], const pg8::Unit& u, int wr, int wc, int fr, int fq) const {
        const int pn = u.pn + (u.sub ? 14 : 0);
        const bool isctx = u.pm >= 64;
        const int bl = isctx ? (u.pm - 64) : (u.pm >> 4);
        const int nseq = isctx ? CTXL : SEQ;
        const int tb = (isctx ? 0 : ((u.pm & 15) * 256)) + wr * 64 + fr;
        const int rbase = u.pm * 256 + wr * 64 + fr;
        if (pn < 4 || pn >= 10) {
            bf16* dst; int ld = 512, c0;
            if (pn < 2) { dst = (bf16*)(U + U_QN); c0 = pn * 256; }
            else if (pn < 4) { dst = (bf16*)(U + U_KN); c0 = (pn - 2) * 256; }
            else if (pn < 12) { dst = (bf16*)(U + U_GR); c0 = (pn - 10) * 256; }
            else if (pn < 14) { dst = (bf16*)(U + U_UP); c0 = (pn - 12) * 256; }
            else { dst = (bf16*)(U + U_G); c0 = (pn - 14) * 256; ld = 3072; }
            bf16* rp0 = dst + (size_t)rbase * ld + c0 + wc * 32 + fq * 4;
#pragma unroll
            for (int ai = 0; ai < 2; ++ai)
#pragma unroll
                for (int m = 0; m < 4; ++m) { bf16* rp = rp0 + (size_t)(ai * 128 + m * 16) * ld;
#pragma unroll
                    for (int bj = 0; bj < 2; ++bj)
#pragma unroll
                        for (int n = 0; n < 2; ++n) { f32x4 v = acc[ai][bj][m][n]; if (pn >= 14) { v[0] = sigm(v[0]); v[1] = sigm(v[1]); v[2] = sigm(v[2]); v[3] = sigm(v[3]); }
                            u32x2 w; w.x = pk2(v[0], v[1]); w.y = pk2(v[2], v[3]); ST8(rp + bj * 128 + n * 16, w); }
                    EPI_FENCE(); }
        } else if (pn < 6 || pn >= 8) {
            const bool nav = pn < 6;
            bf16* dst = (bf16*)(U + (nav ? (isctx ? U_VTC : U_VT) : (isctx ? U_VTRC : U_VTR)));
            const int ccb = (nav ? (pn - 4) : (pn - 8)) * 256 + wc * 32 + fq * 4 + (fr & 3);
            const bool b0 = (fr & 1) != 0, b1 = (fr & 2) != 0;
            bf16* bp0 = dst + (size_t)(bl * 512 + ccb) * nseq + (tb - fr) + 4 * (fr >> 2);
#pragma unroll
            for (int bj = 0; bj < 2; ++bj)
#pragma unroll
                for (int n = 0; n < 2; ++n) { bf16* bp = bp0 + (size_t)(bj * 128 + n * 16) * nseq;
#pragma unroll
                    for (int ai = 0; ai < 2; ++ai)
#pragma unroll
                        for (int m = 0; m < 4; ++m) { const f32x4 w4 = quad_transpose(acc[ai][bj][m][n], b0, b1); u32x2 w; w.x = pk2(w4[0], w4[1]); w.y = pk2(w4[2], w4[3]); *(u32x2*)(bp + ai * 128 + m * 16) = w; }
                    EPI_FENCE(); }
        }
        else {
            bf16* rp0 = (bf16*)(U + (pn == 6 ? U_QR : U_KR)) + (size_t)rbase * 256 + wc * 32 + fq * 4;
#pragma unroll
            for (int ai = 0; ai < 2; ++ai)
#pragma unroll
                for (int m = 0; m < 4; ++m) { bf16* rp = rp0 + (size_t)(ai * 128 + m * 16) * 256;
#pragma unroll
                    for (int bj = 0; bj < 2; ++bj)
#pragma unroll
                        for (int n = 0; n < 2; ++n) { const f32x4 v = acc[ai][bj][m][n]; u32x2 w; w.x = pk2(v[0], v[1]); w.y = pk2(v[2], v[3]); ST8(rp + bj * 128 + n * 16, w); }
                    EPI_FENCE(); }
        }
    }
};

struct EpiNull { static constexpr bool PERM = false, AFTER_DRAIN = false, CHAIN = false; float* sink;
    __device__ __forceinline__ void operator()(f32x4 (&acc)[2][2][4][2], const pg8::Unit& u, int wr, int wc, int fr, int fq) const { f32x4 s = {0.f, 0.f, 0.f, 0.f};
#pragma unroll
        for (int a = 0; a < 2; ++a)
#pragma unroll
            for (int b = 0; b < 2; ++b)
#pragma unroll
                for (int m = 0; m < 4; ++m)
#pragma unroll
                    for (int n = 0; n < 2; ++n) s += acc[a][b][m][n];
        if (s[0] + s[1] + s[2] + s[3] == 1.2345e-33f) sink[0] = 1.f; } };

struct EpiMerge {
    static constexpr bool PERM = false, AFTER_DRAIN = false, CHAIN = true;
    const bf16* G; bf16* Mo;
    __device__ __forceinline__ void operator()(f32x4 (&acc)[2][2][4][2], const pg8::Unit& u, int wr, int wc, int fr, int fq) const {
        const int rbase = u.pm * 256 + wr * 64 + fr, c0 = u.pn * 256 + wc * 32 + fq * 4, sub = u.sub;
#pragma unroll
        for (int ai = 0; ai < 2; ++ai)
#pragma unroll
            for (int m = 0; m < 4; ++m) { const size_t row = (size_t)(rbase + ai * 128 + m * 16); const bf16* gp = G + row * 3072 + c0;
#pragma unroll
                for (int bj = 0; bj < 2; ++bj)
#pragma unroll
                    for (int n = 0; n < 2; ++n) { const int co = bj * 128 + n * 16; f32x4 v = acc[ai][bj][m][n];
                        if (sub < 2) { const u32x2 a = *(const u32x2*)(gp + sub * 1024 + co), b = *(const u32x2*)(gp + (sub + 1) * 1024 + co);
                            v[0] *= bflo(a.x) * __builtin_amdgcn_rcpf(bflo(b.x)); v[1] *= bfhi(a.x) * __builtin_amdgcn_rcpf(bfhi(b.x)); v[2] *= bflo(a.y) * __builtin_amdgcn_rcpf(bflo(b.y)); v[3] *= bfhi(a.y) * __builtin_amdgcn_rcpf(bfhi(b.y));
                            acc[ai][bj][m][n] = v; }
                        else { const u32x2 a = *(const u32x2*)(gp + 2048 + co);
                            v[0] *= bflo(a.x); v[1] *= bfhi(a.x); v[2] *= bflo(a.y); v[3] *= bfhi(a.y);
                            u32x2 w; w.x = pk2(v[0], v[1]); w.y = pk2(v[2], v[3]); ST8(Mo + row * 1024 + c0 + co, w); } } }
    }
};

struct EpiResid {
    static constexpr bool PERM = false, AFTER_DRAIN = false, CHAIN = false;
    const float* base_lat; const float* base_ctx; float* out_lat; float* out_ctx; const float* mod; int lat_tiles, off_lat, off_ctx;
    __device__ __forceinline__ void operator()(f32x4 (&acc)[2][2][4][2], const pg8::Unit& u, int wr, int wc, int fr, int fq) const {
        const bool isctx = u.pm >= lat_tiles;
        const int r0 = (isctx ? off_ctx + (u.pm - lat_tiles) * 256 : off_lat + u.pm * 256);
        const int bidx = isctx ? 8 : (r0 >> 12);
        const float* bp = isctx ? base_ctx : base_lat; float* op = isctx ? out_ctx : out_lat;
        const int c0 = u.pn * 256 + wc * 32 + fq * 4;
        f32x4 mv[2][2];
#pragma unroll
        for (int bj = 0; bj < 2; ++bj)
#pragma unroll
            for (int n = 0; n < 2; ++n) mv[bj][n] = *(const f32x4*)(mod + bidx * NMODC + c0 + bj * 128 + n * 16);
#pragma unroll
        for (int ai = 0; ai < 2; ++ai)
#pragma unroll
            for (int m = 0; m < 4; ++m) { const size_t off = (size_t)(r0 + wr * 64 + fr + ai * 128 + m * 16) * D + c0;
#pragma unroll
                for (int bj = 0; bj < 2; ++bj)
#pragma unroll
                    for (int n = 0; n < 2; ++n) { const f32x4 b = *(const f32x4*)(bp + off + bj * 128 + n * 16); *(f32x4*)(op + off + bj * 128 + n * 16) = b + mv[bj][n] * acc[ai][bj][m][n]; } }
    }
};

struct EpiFfn1 {
    static constexpr bool PERM = false, AFTER_DRAIN = false, CHAIN = false;
    bf16* Hd;
    __device__ __forceinline__ void operator()(f32x4 (&acc)[2][2][4][2], const pg8::Unit& u, int wr, int wc, int fr, int fq) const {
        const int rbase = u.pm * 256 + wr * 64 + fr;
#pragma unroll
        for (int ai = 0; ai < 2; ++ai)
#pragma unroll
            for (int m = 0; m < 4; ++m) { bf16* rp = Hd + (size_t)(rbase + ai * 128 + m * 16) * FF + (u.pn * 256 + wc * 32) / 2 + fq * 4;
#pragma unroll
                for (int bj = 0; bj < 2; ++bj) { const f32x4 g = acc[ai][bj][m][0], up = acc[ai][bj][m][1]; f32x4 h;
#pragma unroll
                    for (int j = 0; j < 4; ++j) h[j] = g[j] * sigm(g[j]) * up[j];
                    u32x2 w; w.x = pk2(h[0], h[1]); w.y = pk2(h[2], h[3]); ST8(rp + bj * 64, w); } }
    }
};

struct Args { const float* in[23]; float* out; unsigned char* ws; int ph_lo, ph_hi; };

__device__ __forceinline__ void transpose_item(const float* W, int K, int N, bf16* WT, int mode, LAS float* scr, int item, int lane) {
    const int nblk = N / 32, kb = item / nblk, nb = item % nblk, k0 = 64 * kb, n0 = 32 * nb;
#pragma unroll 8
    for (int i = 0; i < 32; ++i) { const int kk = 2 * i + (lane >> 5); scr[kk * 33 + (lane & 31)] = W[(size_t)(k0 + kk) * N + n0 + (lane & 31)]; }
    asm volatile("s_waitcnt lgkmcnt(0)" ::: "memory");
    const int c = lane & 7;
#pragma unroll
    for (int j = 0; j < 4; ++j) { const int n = (lane >> 3) + 8 * j; const LAS float* s = scr + (8 * c) * 33 + n;
        u32x4 o; o.x = pk2(s[0 * 33], s[1 * 33]); o.y = pk2(s[2 * 33], s[3 * 33]); o.z = pk2(s[4 * 33], s[5 * 33]); o.w = pk2(s[6 * 33], s[7 * 33]);
        const int nn = n0 + n; const int dr = (mode == 0) ? nn : (nn + 16 * (nn >> 4) + (mode == 2 ? 16 : 0));
        *(u32x4*)(WT + (size_t)dr * K + k0 + 8 * c) = o; }
    asm volatile("s_waitcnt lgkmcnt(0)" ::: "memory");
}

__device__ __forceinline__ void norm_row(const float* src, bf16* dst, const float* gam, const float* shift, const float* scale, int lane) {
    f32x4 v[4]; float ss = 0.f;
#pragma unroll
    for (int j = 0; j < 4; ++j) { v[j] = *(const f32x4*)(src + 4 * lane + 256 * j); ss += (v[j][0] * v[j][0] + v[j][1] * v[j][1]) + (v[j][2] * v[j][2] + v[j][3] * v[j][3]); }
    const float rstd = rsqrtf(wave_sum(ss) * (1.f / D) + 1e-6f);
#pragma unroll
    for (int j = 0; j < 4; ++j) { const int c = 4 * lane + 256 * j; const f32x4 g = *(const f32x4*)(gam + c), sh = *(const f32x4*)(shift + c), sc = *(const f32x4*)(scale + c);
        const f32x4 y = (v[j] * rstd * g) * (sc + 1.0f) + sh; u32x2 w; w.x = pk2(y[0], y[1]); w.y = pk2(y[2], y[3]); ST8(dst + c, w); }
}

__device__ __forceinline__ void rope_item(unsigned char* U, const float* RT, float l2f, float l2b, int row0, int h, int which, int hf0, int lane) {
    const bool isctx = row0 >= LROWS;
    const int row = row0 + lane;
    bf16* p = (bf16*)(U + (which == 0 ? U_QR : U_KR)) + (size_t)row * 256 + h * 64;
    int t, bl, n; if (!isctx) { t = row & (SEQ - 1); bl = row >> 12; n = SEQ; } else { t = (row - LROWS) & (CTXL - 1); bl = (row - LROWS) >> 8; n = CTXL; }
    const int prow = isctx ? 0 : (t >> 6), pcol = isctx ? 0 : (t & 63);
    const float sc = which == 0 ? 1.0f : 0.125f;
    const int pc = t & 127; const float wf = __builtin_amdgcn_exp2f(l2f * (float)(127 - pc)), wb = __builtin_amdgcn_exp2f(l2b * (float)pc);
    bf16* kf = (bf16*)(U + (isctx ? U_KTFC : U_KTF)) + (size_t)((bl * 4 + h) * 64) * n + t;
    bf16* kb = (bf16*)(U + (isctx ? U_KTBC : U_KTB)) + (size_t)((bl * 4 + h) * 64) * n + t;
    { const int hf = hf0;
        const int pos = hf == 0 ? prow : pcol;
        u32x4 w0 = *(const u32x4*)(p + hf * 32), w1 = *(const u32x4*)(p + hf * 32 + 8), w2 = *(const u32x4*)(p + hf * 32 + 16), w3 = *(const u32x4*)(p + hf * 32 + 24);
        float x1[16], x2[16];
#pragma unroll
        for (int i = 0; i < 4; ++i) { x1[2 * i] = bflo(w0[i]); x1[2 * i + 1] = bfhi(w0[i]); x1[8 + 2 * i] = bflo(w1[i]); x1[8 + 2 * i + 1] = bfhi(w1[i]);
            x2[2 * i] = bflo(w2[i]); x2[2 * i + 1] = bfhi(w2[i]); x2[8 + 2 * i] = bflo(w3[i]); x2[8 + 2 * i + 1] = bfhi(w3[i]); }
#pragma unroll
        for (int i = 0; i < 16; ++i) { const f32x2 cs = *(const f32x2*)(RT + (pos * 16 + i) * 2); const float a = x1[i], b = x2[i];
            x1[i] = (a * cs[0] - b * cs[1]) * sc; x2[i] = (a * cs[1] + b * cs[0]) * sc; }
#pragma unroll
        for (int i = 0; i < 4; ++i) { w0[i] = pk2(x1[2 * i], x1[2 * i + 1]); w1[i] = pk2(x1[8 + 2 * i], x1[8 + 2 * i + 1]); w2[i] = pk2(x2[2 * i], x2[2 * i + 1]); w3[i] = pk2(x2[8 + 2 * i], x2[8 + 2 * i + 1]); }
        *(u32x4*)(p + hf * 32) = w0; *(u32x4*)(p + hf * 32 + 8) = w1; *(u32x4*)(p + hf * 32 + 16) = w2; *(u32x4*)(p + hf * 32 + 24) = w3;
        if (which == 1) {
#pragma unroll
            for (int i = 0; i < 16; ++i) { kf[(size_t)(hf * 32 + i) * n] = bf1(x1[i] * wf); kb[(size_t)(hf * 32 + i) * n] = bf1(x1[i] * wb);
                kf[(size_t)(hf * 32 + 16 + i) * n] = bf1(x2[i] * wf); kb[(size_t)(hf * 32 + 16 + i) * n] = bf1(x2[i] * wb); }
        }
        EPI_FENCE();
    }
}

struct NaState { f32x4 o[4]; float mrun, l; };
template <bool ISW>
__device__ __forceinline__ void na_block(NaState& S, const bf16x8 q0, const bf16x8 q1, const bf16* Kp0, const bf16* vb, const LAS unsigned char* kl, const LAS unsigned char* vl,
                                         const LAS float* rp0, int kstart, int qc, int ws_, int fq) {
    f32x4 st[8];
    bf16x8 vw[16];
    if (ISW) {
        bf16x8 kw[16];
#pragma unroll
        for (int t = 0; t < 8; ++t) { const bf16* Kp = Kp0 + (size_t)((t >> 1) * 64 + 4 * (t & 1)) * 512; kw[2 * t] = ld16(Kp); kw[2 * t + 1] = ld16(Kp + 32); }
#pragma unroll
        for (int gi = 0; gi < 4; ++gi)
#pragma unroll
            for (int dt = 0; dt < 4; ++dt) vw[gi * 4 + dt] = ld16(vb + (size_t)dt * 16 * SEQ + gi * 64);
#pragma unroll
        for (int t = 0; t < 8; ++t) { f32x4 z = {0.f, 0.f, 0.f, 0.f}; z = MMA16(kw[2 * t], q0, z); z = MMA16(kw[2 * t + 1], q1, z); st[t] = z; }
    } else {
#pragma unroll
        for (int t = 0; t < 8; ++t) { f32x4 z = {0.f, 0.f, 0.f, 0.f};
            z = MMA16(*(const LAS bf16x8*)(kl + t * 16 * 144), q0, z); z = MMA16(*(const LAS bf16x8*)(kl + t * 16 * 144 + 64), q1, z); st[t] = z; }
    }
    float mx = -1e30f;
#pragma unroll
    for (int t = 0; t < 8; ++t) {
#pragma unroll
        for (int j = 0; j < 4; ++j) { float s = st[t][j] * 0.125f;
            if (ISW) { const int kc = kstart + 8 * fq + 4 * (t & 1) + j; const bool ok = (kc >= ws_) && (kc < ws_ + 16); const int dc = min(max(kc - qc + 15, 0), 30);
                s += rp0[(t >> 1) * 31 + dc]; s = ok ? s : -1e30f; }
            st[t][j] = s; mx = fmaxf(mx, s); } }
    mx = fmaxf(mx, __shfl_xor(mx, 16)); mx = fmaxf(mx, __shfl_xor(mx, 32));
    const float mnew = fmaxf(S.mrun, mx), resc = __builtin_amdgcn_exp2f((S.mrun - mnew) * LOG2E);
    S.mrun = mnew; float ls = 0.f;
#pragma unroll
    for (int t = 0; t < 8; ++t)
#pragma unroll
        for (int j = 0; j < 4; ++j) { const float p = __builtin_amdgcn_exp2f((st[t][j] - mnew) * LOG2E); st[t][j] = p; ls += p; }
    ls += __shfl_xor(ls, 16); ls += __shfl_xor(ls, 32);
    S.l = S.l * resc + ls;
#pragma unroll
    for (int dt = 0; dt < 4; ++dt) S.o[dt] = S.o[dt] * resc;
#pragma unroll
    for (int gi = 0; gi < 4; ++gi) { u32x4 pw; pw.x = pk2(st[2 * gi][0], st[2 * gi][1]); pw.y = pk2(st[2 * gi][2], st[2 * gi][3]); pw.z = pk2(st[2 * gi + 1][0], st[2 * gi + 1][1]); pw.w = pk2(st[2 * gi + 1][2], st[2 * gi + 1][3]);
        const bf16x8 pf = __builtin_bit_cast(bf16x8, pw);
        if (ISW) {
#pragma unroll
            for (int dt = 0; dt < 4; ++dt) S.o[dt] = MMA16(vw[gi * 4 + dt], pf, S.o[dt]);
        } else {
#pragma unroll
            for (int dt = 0; dt < 4; ++dt) S.o[dt] = MMA16(*(const LAS bf16x8*)(vl + dt * 16 * 528 + gi * 64), pf, S.o[dt]);
        } }
}
__device__ __forceinline__ void na_block_lw(NaState& S, const bf16x8 q0, const bf16x8 q1, const LAS unsigned char* Kl, const LAS unsigned char* Vl, const LAS float* rph,
                                            int rowb, int grow, int r0, int kstart, int qc, int ws_, int fr, int fq) {
    f32x4 st[8];
    const LAS unsigned char* kl = Kl + (size_t)(kstart + 8 * (fr >> 2) + (fr & 3)) * 144 + fq * 16;
#pragma unroll
    for (int t = 0; t < 8; ++t) { const LAS unsigned char* kp = kl + ((t >> 1) * 64 + 4 * (t & 1)) * 144; f32x4 z = {0.f, 0.f, 0.f, 0.f};
        z = MMA16(*(const LAS bf16x8*)kp, q0, z); z = MMA16(*(const LAS bf16x8*)(kp + 64), q1, z); st[t] = z; }
    float mx = -1e30f;
#pragma unroll
    for (int t = 0; t < 8; ++t) { const int kra = rowb + (t >> 1); const bool rowok = (kra >= r0) && (kra <= r0 + 7); const int dr = min(max(kra - grow + 7, 0), 14);
        const LAS float* rpr = rph + dr * 31;
#pragma unroll
        for (int j = 0; j < 4; ++j) { const int kc = kstart + 8 * fq + 4 * (t & 1) + j; const bool ok = rowok && (kc >= ws_) && (kc < ws_ + 16); const int dc = min(max(kc - qc + 15, 0), 30);
            float s = st[t][j] * 0.125f + rpr[dc]; s = ok ? s : -1e30f; st[t][j] = s; mx = fmaxf(mx, s); } }
    mx = fmaxf(mx, __shfl_xor(mx, 16)); mx = fmaxf(mx, __shfl_xor(mx, 32));
    const float mnew = fmaxf(S.mrun, mx), resc = __builtin_amdgcn_exp2f((S.mrun - mnew) * LOG2E);
    S.mrun = mnew; float ls = 0.f;
#pragma unroll
    for (int t = 0; t < 8; ++t)
#pragma unroll
        for (int j = 0; j < 4; ++j) { const float p = __builtin_amdgcn_exp2f((st[t][j] - mnew) * LOG2E); st[t][j] = p; ls += p; }
    ls += __shfl_xor(ls, 16); ls += __shfl_xor(ls, 32);
    S.l = S.l * resc + ls;
#pragma unroll
    for (int dt = 0; dt < 4; ++dt) S.o[dt] = S.o[dt] * resc;
    const LAS unsigned char* vl = Vl + (size_t)fr * 528 + (kstart + 8 * fq) * 2;
#pragma unroll
    for (int gi = 0; gi < 4; ++gi) { u32x4 pw; pw.x = pk2(st[2 * gi][0], st[2 * gi][1]); pw.y = pk2(st[2 * gi][2], st[2 * gi][3]); pw.z = pk2(st[2 * gi + 1][0], st[2 * gi + 1][1]); pw.w = pk2(st[2 * gi + 1][2], st[2 * gi + 1][3]);
        const bf16x8 pf = __builtin_bit_cast(bf16x8, pw);
#pragma unroll
        for (int dt = 0; dt < 4; ++dt) S.o[dt] = MMA16(*(const LAS bf16x8*)(vl + dt * 16 * 528 + gi * 128), pf, S.o[dt]); }
}
template <bool WIN>
__device__ __forceinline__ void na_item(unsigned char* U, bf16* Aout, const LAS float* rp, const LAS unsigned char* Kl, const LAS unsigned char* Vl, int bl, int h, int qrow0, int grow, int cb, int lane) {
    const int fr = lane & 15, fq = lane >> 4;
    const bf16* QN = (const bf16*)(U + U_QN); const bf16* KN = (const bf16*)(U + U_KN); const bf16* VT = (const bf16*)(U + U_VT);
    const bf16* Qp = QN + (size_t)(qrow0 + fr) * 512 + h * 64 + fq * 8;
    const bf16x8 q0 = ld16(Qp), q1 = ld16(Qp + 32);
    const int r0 = min(max(grow - 4, 0), 56), kstart = min(max(16 * cb - 8, 0), 32), koff = 8 * (fr >> 2) + (fr & 3);
    const int qc = 16 * cb + fr, ws_ = min(max(qc - 8, 0), 48);
    NaState S;
#pragma unroll
    for (int dt = 0; dt < 4; ++dt) S.o[dt] = (f32x4){0.f, 0.f, 0.f, 0.f};
    S.mrun = -1e30f; S.l = 0.f;
    if (WIN) {
#pragma unroll 1
        for (int blk = 0; blk < 2; ++blk) {
            const bf16* Kp0 = KN + (size_t)(bl * SEQ + (r0 + 4 * blk) * 64 + kstart + koff) * 512 + h * 64 + fq * 8;
            const bf16* vb = VT + (size_t)((bl * 8 + h) * 64 + fr) * SEQ + (r0 + 4 * blk) * 64 + kstart + 8 * fq;
            na_block<true>(S, q0, q1, Kp0, vb, Kl, Vl, rp + (h * 15 + (r0 + 4 * blk - grow + 7)) * 31, kstart, qc, ws_, fq);
            EPI_FENCE();
        }
    }
#pragma unroll 1
    for (int blk = 0; blk < 2; ++blk) {
        na_block<false>(S, q0, q1, KN, VT, Kl + (size_t)(128 * blk + fr) * 144 + fq * 16, Vl + (size_t)fr * 528 + (128 * blk + 8 * fq) * 2, rp, 0, 0, 0, fq);
        EPI_FENCE();
    }
    const float inv = 1.f / S.l;
    bf16* op = Aout + (size_t)(qrow0 + fr) * 512 + h * 64 + 4 * fq;
#pragma unroll
    for (int dt = 0; dt < 4; ++dt) { u32x2 w; w.x = pk2(S.o[dt][0] * inv, S.o[dt][1] * inv); w.y = pk2(S.o[dt][2] * inv, S.o[dt][3] * inv); ST8(op + dt * 16, w); }
}

template <int GI>
__device__ __forceinline__ void pool_item(unsigned char* U, const bf16* PW, const float* pscale, bf16* Pout, int row0, int lane) {
    constexpr int g = GI, W = 2 << GI, hw = 1 << GI;
    const int fr = lane & 15, fq = lane >> 4;
    const bf16* UP = (const bf16*)(U + U_UP);
    const int row = row0 + fr;
    int t, n; if (row < LROWS) { t = row & (SEQ - 1); n = SEQ; } else { t = (row - LROWS) & (CTXL - 1); n = CTXL; }
    const int sbase = row - t;
    const int lo = max(t - hw, 0), hi = min(t + hw, n);
    const float inv = 1.f / (float)(hi - lo);
    f32x4 acc[8];
#pragma unroll
    for (int dt = 0; dt < 8; ++dt) acc[dt] = (f32x4){0.f, 0.f, 0.f, 0.f};
#pragma unroll
    for (int ks = 0; ks < 4; ++ks) { const int c0 = g * 128 + ks * 32 + fq * 8;
        float s0 = 0.f, s1 = 0.f, s2 = 0.f, s3 = 0.f, s4 = 0.f, s5 = 0.f, s6 = 0.f, s7 = 0.f;
        constexpr int WC = W < 8 ? W : 8;
        const u32x4 me = *(const u32x4*)(UP + (size_t)row * 512 + c0);
#pragma unroll
        for (int i0 = 0; i0 < W; i0 += WC) {
            u32x4 wv[WC];
#pragma unroll
            for (int i = 0; i < WC; ++i) { const int tt = min(max(t - hw + i0 + i, 0), n - 1); wv[i] = *(const u32x4*)(UP + (size_t)(sbase + tt) * 512 + c0); }
#pragma unroll
            for (int i = 0; i < WC; ++i) { const int tt = t - hw + i0 + i; const float ok = (tt >= 0 && tt < n) ? 1.f : 0.f; const u32x4 v = wv[i];
                s0 += ok * bflo(v.x); s1 += ok * bfhi(v.x); s2 += ok * bflo(v.y); s3 += ok * bfhi(v.y); s4 += ok * bflo(v.z); s5 += ok * bfhi(v.z); s6 += ok * bflo(v.w); s7 += ok * bfhi(v.w); }
            EPI_FENCE();
        }
        u32x4 pw; pw.x = pk2(s0 * inv - bflo(me.x), s1 * inv - bfhi(me.x)); pw.y = pk2(s2 * inv - bflo(me.y), s3 * inv - bfhi(me.y));
        pw.z = pk2(s4 * inv - bflo(me.z), s5 * inv - bfhi(me.z)); pw.w = pk2(s6 * inv - bflo(me.w), s7 * inv - bfhi(me.w));
        const bf16x8 pf = __builtin_bit_cast(bf16x8, pw);
        EPI_FENCE();
#pragma unroll
        for (int dt = 0; dt < 8; ++dt) { const bf16x8 wf = ld16(PW + (size_t)(g * 128 + dt * 16 + fr) * 128 + ks * 32 + fq * 8); acc[dt] = MMA16(wf, pf, acc[dt]); if ((dt & 3) == 3) EPI_FENCE(); }
        }
#pragma unroll
    for (int dt = 0; dt < 8; ++dt) { const int col = g * 128 + dt * 16 + 4 * fq; const f32x4 sc = *(const f32x4*)(pscale + col); const f32x4 y = acc[dt] * sc;
        u32x2 w; w.x = pk2(y[0], y[1]); w.y = pk2(y[2], y[3]); ST8(Pout + (size_t)row * 512 + col, w); }
}

__device__ __forceinline__ void contrib_item(unsigned char* U, float* ST, int bl, int h, bool isctx, int C, int dvt, int lane) {
    const int fr = lane & 15, fq = lane >> 4;
    const int n = isctx ? CTXL : SEQ;
    const bf16* VTR = (const bf16*)(U + (isctx ? U_VTRC : U_VTR));
    bf16x8 vf[4];
#pragma unroll
    for (int ks = 0; ks < 4; ++ks) vf[ks] = ld16(VTR + (size_t)((bl * 4 + h) * 128 + dvt * 16 + fr) * n + C * 128 + ks * 32 + fq * 8);
#pragma unroll
    for (int dir = 0; dir < 2; ++dir) {
        const bf16* KT = (const bf16*)(U + (dir == 0 ? (isctx ? U_KTFC : U_KTF) : (isctx ? U_KTBC : U_KTB)));
        const int step = dir == 0 ? (isctx ? C : 2 + C) : (isctx ? 1 - C : 2 + 31 - C);
        float* sp = ST + ((size_t)(((bl * 4 + h) * 2 + dir) * 34 + step)) * 8192 + (dvt * 16 + 4 * fq) * 64 + fr;
#pragma unroll
        for (int dkt = 0; dkt < 4; ++dkt) { f32x4 a = {0.f, 0.f, 0.f, 0.f};
#pragma unroll
            for (int ks = 0; ks < 4; ++ks) { const bf16x8 kf = ld16(KT + (size_t)((bl * 4 + h) * 64 + dkt * 16 + fr) * n + C * 128 + ks * 32 + fq * 8); a = MMA16(vf[ks], kf, a); }
#pragma unroll
            for (int j = 0; j < 4; ++j) sp[j * 64 + dkt * 16] = a[j];
            EPI_FENCE(); }
    }
}

constexpr int RO_K = 0, RO_V = 18432, RO_PF = 18432 + 34816, RO_PB = RO_PF + 18432, RO_END = RO_PB + 18432;
__device__ __forceinline__ void retout_item(unsigned char* U, const LAS unsigned char* L, bf16* Rout, const float* gn, float l2f, float l2b, int bl, int h, bool isctx, int C, int qt, int lane) {
    const int fr = lane & 15, fq = lane >> 4;
    const int rowbase = isctx ? (LROWS + bl * CTXL) : bl * SEQ;
    const bf16* QR = (const bf16*)(U + U_QR); const bf16* GR = (const bf16*)(U + U_GR);
    const int row = rowbase + C * 128 + qt * 16 + fr;
    const bf16* Qp = QR + (size_t)row * 256 + h * 64 + fq * 8;
    const bf16x8 q0 = ld16(Qp), q1 = ld16(Qp + 32);
    const int nq = qt * 16 + fr;
    f32x4 st[8];
    const LAS unsigned char* kl = L + RO_K + fr * 144 + fq * 16;
#pragma unroll
    for (int t = 0; t < 8; ++t) {
        f32x4 z = {0.f, 0.f, 0.f, 0.f}; z = MMA16(*(const LAS bf16x8*)(kl + t * 16 * 144), q0, z); z = MMA16(*(const LAS bf16x8*)(kl + t * 16 * 144 + 64), q1, z);
#pragma unroll
        for (int j = 0; j < 4; ++j) { const int mm = 32 * (t >> 1) + 8 * fq + 4 * (t & 1) + j; const int dl = nq - mm; const float w = __builtin_amdgcn_exp2f(dl >= 0 ? l2f * (float)dl : l2b * (float)(-dl)); z[j] *= w; }
        st[t] = z; }
    f32x4 o[8];
#pragma unroll
    for (int dt = 0; dt < 8; ++dt) o[dt] = (f32x4){0.f, 0.f, 0.f, 0.f};
    const LAS unsigned char* vl = L + RO_V + fr * 272 + fq * 16;
#pragma unroll
    for (int gi = 0; gi < 4; ++gi) { u32x4 pw; pw.x = pk2(st[2 * gi][0], st[2 * gi][1]); pw.y = pk2(st[2 * gi][2], st[2 * gi][3]); pw.z = pk2(st[2 * gi + 1][0], st[2 * gi + 1][1]); pw.w = pk2(st[2 * gi + 1][2], st[2 * gi + 1][3]);
        const bf16x8 pf = __builtin_bit_cast(bf16x8, pw);
#pragma unroll
        for (int dt = 0; dt < 8; ++dt) o[dt] = MMA16(*(const LAS bf16x8*)(vl + dt * 16 * 272 + gi * 64), pf, o[dt]);
        EPI_FENCE(); }
    const float xf = __builtin_amdgcn_exp2f(l2f * (float)(nq + 1)), xb = __builtin_amdgcn_exp2f(l2b * (float)(128 - nq));
    const LAS unsigned char* pfl = L + RO_PF + fr * 144 + fq * 16; const LAS unsigned char* pbl = L + RO_PB + fr * 144 + fq * 16;
#pragma unroll
    for (int dt = 0; dt < 8; ++dt) { f32x4 cf = {0.f, 0.f, 0.f, 0.f}, cb = {0.f, 0.f, 0.f, 0.f};
        cf = MMA16(*(const LAS bf16x8*)(pfl + dt * 16 * 144), q0, cf); cf = MMA16(*(const LAS bf16x8*)(pfl + dt * 16 * 144 + 64), q1, cf);
        cb = MMA16(*(const LAS bf16x8*)(pbl + dt * 16 * 144), q0, cb); cb = MMA16(*(const LAS bf16x8*)(pbl + dt * 16 * 144 + 64), q1, cb);
        o[dt] = o[dt] + cf * xf + cb * xb; if (dt & 1) EPI_FENCE(); }
    float s = 0.f;
#pragma unroll
    for (int dt = 0; dt < 8; ++dt) s += (o[dt][0] + o[dt][1]) + (o[dt][2] + o[dt][3]);
    s += __shfl_xor(s, 16); s += __shfl_xor(s, 32);
    const float mu = s * (1.f / 128.f); float q = 0.f;
#pragma unroll
    for (int dt = 0; dt < 8; ++dt) { const f32x4 d = o[dt] - mu; q += (d[0] * d[0] + d[1] * d[1]) + (d[2] * d[2] + d[3] * d[3]); }
    q += __shfl_xor(q, 16); q += __shfl_xor(q, 32);
    const float rstd = rsqrtf(q * (1.f / 128.f) + 1e-5f);
#pragma unroll
    for (int dt = 0; dt < 8; ++dt) { const int col = h * 128 + dt * 16 + 4 * fq; const f32x4 gg = *(const f32x4*)(gn + col); const u32x2 gw = *(const u32x2*)(GR + (size_t)row * 512 + col);
        const float g0 = bflo(gw.x), g1 = bfhi(gw.x), g2 = bflo(gw.y), g3 = bfhi(gw.y);
        const f32x4 y = (o[dt] - mu) * rstd * gg;
        u32x2 w; w.x = pk2(g0 * sigm(g0) * y[0], g1 * sigm(g1) * y[1]); w.y = pk2(g2 * sigm(g2) * y[2], g3 * sigm(g3) * y[3]);
        ST8(Rout + (size_t)row * 512 + col, w); }
}

#define RLX_AGENT __ATOMIC_RELAXED, __HIP_MEMORY_SCOPE_AGENT
#define XB_TMO      128
#define XB_XCNT(j)  (256  + 64 * (j))
#define XB_XSUB(j)  (1280 + 64 * (j))
#define XB_XGEN(j)  (2304 + 64 * (j))
#define XB_TOP      3328
#define XB_TOPGEN   3392
#define XCD_BAR_WORDS 3456
#define XB_SPIN_CAP (1u << 18)

__device__ __forceinline__ unsigned xb_ld(unsigned* p)              { return __hip_atomic_load(p, __ATOMIC_RELAXED, __HIP_MEMORY_SCOPE_AGENT); }
__device__ __forceinline__ unsigned xb_add(unsigned* p, unsigned v) { return __hip_atomic_fetch_add(p, v, __ATOMIC_RELAXED, __HIP_MEMORY_SCOPE_AGENT); }
__device__ __forceinline__ unsigned xb_xcc_id() { return (unsigned)__builtin_amdgcn_s_getreg((3 << 11) | 20) & 0xFu; }
#define XB_SPIN(cond, bar) do { unsigned _sp = 0; while (cond) { __builtin_amdgcn_s_sleep(1); \
    if ((++_sp & 255u) == 0u) { if (xb_ld(&(bar)[XB_TMO])) break; if (_sp > XB_SPIN_CAP) { atomicAdd(&(bar)[XB_TMO], 1u); break; } } } } while (0)

struct XcdBarrier {
    unsigned* bar; unsigned x;
    volatile LAS unsigned* st;
};

__device__ __forceinline__ XcdBarrier xcd_barrier_post(unsigned* bar, volatile LAS unsigned* st) {
    XcdBarrier b; b.bar = bar; b.x = xb_xcc_id(); b.st = st;
    if (threadIdx.x == 0) (void)xb_add(&bar[XB_XCNT(b.x)], 1u);
    return b;
}
__device__ __forceinline__ void xcd_barrier_complete(unsigned* bar, unsigned x, unsigned& nloc, unsigned& nx) {
    const unsigned G = gridDim.x * gridDim.y * gridDim.z;
    unsigned sum, cnt, mine, sp = 0u;
    for (;;) {
        sum = 0u; cnt = 0u; mine = 0u;
#pragma unroll
        for (unsigned j = 0; j < 16; ++j) { const unsigned c = xb_ld(&bar[XB_XCNT(j)]); sum += c; cnt += (c > 0u) ? 1u : 0u; mine = (j == x) ? c : mine; }
        if (sum == G) break;
        __builtin_amdgcn_s_sleep(1);
        if ((++sp & 255u) == 0u) { if (xb_ld(&bar[XB_TMO])) break; if (sp > XB_SPIN_CAP) { atomicAdd(&bar[XB_TMO], 1u); break; } }
    }
    nloc = mine > 0u ? mine : 1u; nx = cnt > 0u ? cnt : 1u;
}

__device__ __forceinline__ void xcd_barrier(const XcdBarrier& b) {
    asm volatile("s_waitcnt vmcnt(0)" ::: "memory");
    __syncthreads();
    if (threadIdx.x == 0) {
        unsigned* bar = b.bar;
        __builtin_amdgcn_s_waitcnt(0);
        unsigned nloc = b.st[0], nx = b.st[1];
        if (nloc == 0u) { xcd_barrier_complete(bar, b.x, nloc, nx); b.st[0] = nloc; b.st[1] = nx; }
        const unsigned old = xb_add(&bar[XB_XSUB(b.x)], 1u);
        const unsigned gen = old / nloc;
        if (old + 1u == (gen + 1u) * nloc) {
            __builtin_amdgcn_fence(__ATOMIC_RELEASE, "agent");
            asm volatile("s_waitcnt vmcnt(0)" ::: "memory");
            const unsigned og = xb_add(&bar[XB_TOP], 1u);
            const unsigned tg = og / nx;
            if (og + 1u == (tg + 1u) * nx) xb_add(&bar[XB_TOPGEN], 1u);
            else XB_SPIN(xb_ld(&bar[XB_TOPGEN]) == tg, bar);
            __builtin_amdgcn_fence(__ATOMIC_ACQUIRE, "agent");
            xb_add(&bar[XB_XGEN(b.x)], 1u);
            asm volatile("s_waitcnt vmcnt(0)" ::: "memory");
        } else {
            XB_SPIN(xb_ld(&bar[XB_XGEN(b.x)]) == gen, bar);
            __builtin_amdgcn_fence(__ATOMIC_ACQUIRE, "agent");
            asm volatile("s_waitcnt vmcnt(0)" ::: "memory");
        }
    }
    __syncthreads();
}

__global__ void __launch_bounds__(NWAVES * 64, 2) fwd_megakernel(Args args) {
    extern __shared__ __attribute__((aligned(16))) unsigned char lds_raw[];
    LAS unsigned char* lds = (LAS unsigned char*)lds_raw;
    cg::grid_group grid = cg::this_grid();
    const int tid0 = threadIdx.x, wave = __builtin_amdgcn_readfirstlane(tid0 >> 6);
    const int G = gridDim.x, gw = blockIdx.x * NWAVES + wave, NGW = G * NWAVES;
    unsigned char* ws = args.ws;
    const float* x = args.in[0]; const float* cvec = args.in[1]; const float* ctx = args.in[2]; const float* cctx = args.in[3];
    float* out = args.out; float* HC = (float*)(ws + WS_HC);
    float* MOD = (float*)(ws + WS_MOD); float* RT = (float*)(ws + WS_RT);
    unsigned char* U = ws + WS_U;
    const int lo = args.ph_lo, hi = args.ph_hi;
    int pid = 0;
    if (tid0 < 64) ((LAS unsigned*)(lds + 131072))[tid0] = 0u;
    if (blockIdx.x == 0 && lo == 0) { unsigned* bw = (unsigned*)(ws + WS_BAR); for (int i = tid0; i < XCD_BAR_WORDS; i += NWAVES * 64) __hip_atomic_store(bw + i, 0u, __ATOMIC_RELAXED, __HIP_MEMORY_SCOPE_AGENT); }
    __syncthreads();
    XcdBarrier xbar; xbar.bar = (unsigned*)(ws + WS_BAR); xbar.x = 0; xbar.st = nullptr;
#define PH_BEGIN if (pid >= lo && pid < hi) { int tid = tid0; asm volatile("" : "+v"(tid)); const int lane = tid & 63; (void)lane;
#define PH_END } if (pid >= lo && pid + 1 < hi) { if (pid == 0) { grid.sync(); xbar = xcd_barrier_post((unsigned*)(ws + WS_BAR), (volatile LAS unsigned*)(lds + 131072)); } else { for (int s_ = 0; s_ < NSYNC; ++s_) xcd_barrier(xbar); } } ++pid;

    PH_BEGIN
#ifndef OFF0
#pragma unroll 1
            for (int rep_ = 0; rep_ < REP0; ++rep_) {
    {
        LAS float* sv = (LAS float*)lds;
        LAS float* red = (LAS float*)(lds + 40960);
        for (int i = tid; i < 9 * D; i += NWAVES * 64) { const float v = (i < 8 * D) ? cvec[i] : cctx[i - 8 * D]; sv[i] = v / (1.f + expf(-v)); }
        __syncthreads();
        for (int item = blockIdx.x; item < 2 * 96; item += G) {
            const int l = item / 96, col = (item % 96) * 64 + lane;
            const float* wa = args.in[6] + (size_t)l * D * NMODC + col;
            float a[9];
#pragma unroll
            for (int b = 0; b < 9; ++b) a[b] = 0.f;
#pragma unroll 16
            for (int kk = 0; kk < 128; ++kk) { const int k = wave * 128 + kk; const float wv = wa[(size_t)k * NMODC];
#pragma unroll
                for (int b = 0; b < 9; ++b) a[b] += sv[b * D + k] * wv; }
#pragma unroll
            for (int b = 0; b < 9; ++b) red[(wave * 9 + b) * 64 + lane] = a[b];
            __syncthreads();
            for (int o = tid; o < 9 * 64; o += NWAVES * 64) { const int b = o >> 6, ln = o & 63; float s = 0.f;
#pragma unroll
                for (int w = 0; w < 8; ++w) s += red[(w * 9 + b) * 64 + ln];
                const int cc = (item % 96) * 64 + ln; MOD[((size_t)l * 9 + b) * NMODC + cc] = s + args.in[7][(size_t)l * NMODC + cc]; }
            __syncthreads();
        }
        if (blockIdx.x == G - 1) { for (int i = tid; i < 64 * 16; i += NWAVES * 64) { const int pos = i >> 4, f = i & 15; const float inv = powf(10000.f, -(float)f / 16.f); const float ang = (float)pos * inv;
            RT[2 * i] = cosf(ang); RT[2 * i + 1] = sinf(ang); } }
        __syncthreads();
        LAS float* scr = (LAS float*)(lds + wave * 16384);
        constexpr int I_IN = 16 * (INW / 32), I_BR = 8 * 32, I_O = 16 * 32, I_G = 16 * (FF / 32), I_D = (FF / 64) * 32, I_P = 2 * 4;
        constexpr int I_LAYER = I_IN + 3 * I_BR + I_O + 2 * I_G + I_D + 4 * I_P;
        for (int it = gw; it < 2 * I_LAYER; it += NGW) {
            const int l = it / I_LAYER; int r = it - l * I_LAYER; unsigned char* wl = ws + WS_W + (size_t)l * WL_STRIDE;
            if (r < I_IN) { transpose_item(args.in[8] + (size_t)l * D * INW, D, INW, (bf16*)(wl + W_IN), 0, scr, r, lane); continue; } r -= I_IN;
            if (r < I_BR) { transpose_item(args.in[15] + (size_t)l * 512 * D, 512, D, (bf16*)(wl + W_BA), 0, scr, r, lane); continue; } r -= I_BR;
            if (r < I_BR) { transpose_item(args.in[16] + (size_t)l * 512 * D, 512, D, (bf16*)(wl + W_BB), 0, scr, r, lane); continue; } r -= I_BR;
            if (r < I_BR) { transpose_item(args.in[17] + (size_t)l * 512 * D, 512, D, (bf16*)(wl + W_BC), 0, scr, r, lane); continue; } r -= I_BR;
            if (r < I_O) { transpose_item(args.in[18] + (size_t)l * D * D, D, D, (bf16*)(wl + W_O), 0, scr, r, lane); continue; } r -= I_O;
            if (r < I_G) { transpose_item(args.in[19] + (size_t)l * D * FF, D, FF, (bf16*)(wl + W_GU), 1, scr, r, lane); continue; } r -= I_G;
            if (r < I_G) { transpose_item(args.in[20] + (size_t)l * D * FF, D, FF, (bf16*)(wl + W_GU), 2, scr, r, lane); continue; } r -= I_G;
            if (r < I_D) { transpose_item(args.in[21] + (size_t)l * FF * D, FF, D, (bf16*)(wl + W_D), 0, scr, r, lane); continue; } r -= I_D;
            { const int g = r / I_P; transpose_item(args.in[13] + ((size_t)l * 4 + g) * 128 * 128, 128, 128, (bf16*)(wl + W_P) + (size_t)g * 128 * 128, 0, scr, r % I_P, lane); }
        }
        __syncthreads();
    }
            }
#endif
    PH_END

#pragma unroll 1
    for (int l = 0; l < 2; ++l) {
        const bool with_ctx = (l == 0);
        unsigned char* wl = ws + WS_W + (size_t)l * WL_STRIDE;
        const float* modl = MOD + (size_t)l * 9 * NMODC;
        const float* hl = (l == 0) ? x : out; const float* hcs = (l == 0) ? ctx : HC;
        PH_BEGIN
#ifndef OFF1
#pragma unroll 1
            for (int rep_ = 0; rep_ < REP1; ++rep_) {
            for (int rr = gw; rr < 2 * HROWS; rr += NGW) {
                const int g = rr >= HROWS ? 1 : 0, r = rr - g * HROWS;
                const float* src; int bidx;
                if (r < LROWS) { const int gr = g * LROWS + r; src = hl + (size_t)gr * D; bidx = gr >> 12; } else { const int gc = g * CROWS + (r - LROWS); src = hcs + (size_t)gc * D; bidx = 8; }
                norm_row(src, (bf16*)(ws + WS_XN) + (size_t)rr * D, args.in[4] + l * D, modl + bidx * NMODC, modl + bidx * NMODC + D, lane);
            }
            }
#endif
        PH_END
#pragma unroll 1
        for (int s = 0; s < 3; ++s) {
            PH_BEGIN
            if (s == 2) {
                const int g = 1;
                const int Mr = with_ctx ? HROWS : LROWS;
                pg8::Gemm gm{(const bf16*)(ws + WS_XN + g * XN_HALF), (const bf16*)(wl + W_O), 0, 0, Mr, D, D};
                pg8::StaticOrder S; S.init(Mr, D, G, (int)blockIdx.x);
                EpiResid E{hl, hcs, out, HC, modl + 2 * D, LROWS / 256, g * LROWS, g * CROWS};
                pg8::gemm_phase<EpiResid, pg8::StaticOrder, ALIGN_SMALL, true>(lds, gm, S, E);
            }
            if (s == 2) {
                for (int q = NGW - 1 - gw; q < (with_ctx ? HROWS : LROWS); q += NGW) {
                    const int r = q < LROWS ? q : TLAT + (q - LROWS);
                    const float* src; int bidx;
                    if (r < TLAT) { src = out + (size_t)r * D; bidx = r >> 12; } else { src = HC + (size_t)(r - TLAT) * D; bidx = 8; }
                    norm_row(src, (bf16*)(ws + WS_FX) + (size_t)r * D, args.in[5] + l * D, modl + bidx * NMODC + 3 * D, modl + bidx * NMODC + 4 * D, lane);
                }
            }
            if (s < 2) {
                const int g = s;
                EpiInproj E{U};
                if (g == 1 && with_ctx) {
                    pg8::Gemm gm{(const bf16*)(ws + WS_XN + g * XN_HALF), (const bf16*)(wl + W_IN), 0, (long)3584 * D, HROWS, INW, D};
                    pg8::InprojOrder S; S.SA.init(HROWS, 3584, 1, 0); S.SB.init(HROWS, 3072, 1, 0); S.lo = IP_TAIL; S.nA = (HROWS / 256) * 14 - IP_TAIL; S.nB = (HROWS / 256) * 12; S.G = G; S.c = (int)blockIdx.x;
                    pg8::gemm_phase<EpiInproj, pg8::InprojOrder, true, true>(lds, gm, S, E);
                } else {
                    pg8::Gemm gm{(const bf16*)(ws + WS_XN + g * XN_HALF), (const bf16*)(wl + W_IN), 0, 0, HROWS, INW, D};
                    pg8::StaticOrder S; S.init(HROWS, INW, G, (int)blockIdx.x);
                    pg8::gemm_phase<EpiInproj, pg8::StaticOrder, true, true>(lds, gm, S, E);
                }
            }
            PH_END
            if (s < 2) {
            const int g = s;
            PH_BEGIN
#ifndef OFF3
#pragma unroll 1
            for (int rep_ = 0; rep_ < REP3; ++rep_) {
            {
                constexpr int NA_K_OFF = 0, NA_V_OFF = 36864, NA_RP_OFF = 36864 + 33792;
                LAS float* rp = (LAS float*)(lds + NA_RP_OFF);
                for (int i = tid; i < 8 * 15 * 31; i += NWAVES * 64) rp[i] = args.in[9][(size_t)l * 8 * 15 * 31 + i];
                bf16* Aout = (bf16*)(ws + WS_ARP); bf16* Pout = (bf16*)(ws + WS_ARP + 34 * MiB);
                const int vcu = (G % 8 == 0) ? ((int)blockIdx.x % 8) * (G / 8) + (int)blockIdx.x / 8 : (int)blockIdx.x;
                const int nb_na = HB * 8 * 8, nb_nac = 0;
#ifndef M1_NO_NA
#pragma unroll 1
                for (int bi = vcu; bi < nb_na; bi += G) {
                    const int rg = bi & 7, h = (bi >> 3) & 7, bl = bi >> 6, R = rg * 8;
                    const int fr = lane & 15, fq = lane >> 4, cb = wave & 3, rw = R + (wave >> 2) * 4;
                    const int kstart = min(max(16 * cb - 8, 0), 32), qc = 16 * cb + fr, ws_ = min(max(qc - 8, 0), 48);
                    NaState S4[4];
                    const bf16* Qp0 = (const bf16*)(U + U_QN) + (size_t)(bl * SEQ + rw * 64 + cb * 16 + fr) * 512 + h * 64 + fq * 8;
                    __syncthreads();
                    {
                        const bf16* KN = (const bf16*)(U + U_KN) + (size_t)(LROWS + bl * CTXL) * 512 + h * 64; const bf16* VTC = (const bf16*)(U + U_VTC) + (size_t)((bl * 8 + h) * 64) * CTXL;
#pragma unroll
                        for (int i = 0; i < 4; ++i) { const int ch = tid + i * 512; const int key = ch >> 3, c = ch & 7;
                            const int rho = (key & ~31) + 16 * ((key >> 2) & 1) + 4 * ((key >> 3) & 3) + (key & 3);
                            *(LAS u32x4*)(lds + NA_K_OFF + rho * 144 + c * 16) = *(const u32x4*)(KN + (size_t)key * 512 + c * 8); }
#pragma unroll
                        for (int i = 0; i < 4; ++i) { const int ch = tid + i * 512; const int d = ch >> 5, c = ch & 31;
                            *(LAS u32x4*)(lds + NA_V_OFF + d * 528 + c * 16) = *(const u32x4*)(VTC + (size_t)d * CTXL + c * 8); }
                    }
                    __syncthreads();
                    if (with_ctx && wave < 2)
                        na_item<false>(U, Aout, rp, lds + NA_K_OFF, lds + NA_V_OFF, bl, h, LROWS + bl * CTXL + (rg * 2 + wave) * 16, 0, 0, lane);
                    EPI_FENCE();
#pragma unroll
                    for (int i = 0; i < 4; ++i) {
#pragma unroll
                        for (int dt = 0; dt < 4; ++dt) S4[i].o[dt] = (f32x4){0.f, 0.f, 0.f, 0.f};
                        S4[i].mrun = -1e30f; S4[i].l = 0.f; }
#pragma unroll
                    for (int i = 0; i < 4; ++i) {
#pragma unroll 1
                        for (int blk = 0; blk < 2; ++blk) { na_block<false>(S4[i], ld16(Qp0 + (size_t)i * 64 * 512), ld16(Qp0 + (size_t)i * 64 * 512 + 32), nullptr, nullptr, lds + NA_K_OFF + (size_t)(128 * blk + fr) * 144 + fq * 16, lds + NA_V_OFF + (size_t)fr * 528 + (128 * blk + 8 * fq) * 2, rp, 0, 0, 0, fq); EPI_FENCE(); } }
#pragma unroll 1
                    for (int kb = 0; kb < 4; ++kb) {
                        const int rowb = R - 4 + 4 * kb;
                        if (rowb + 3 < 0 || rowb > 63) continue;
                        __syncthreads();
                        {
                            const bf16* KNb = (const bf16*)(U + U_KN) + (size_t)(bl * SEQ) * 512 + h * 64; const bf16* VTb = (const bf16*)(U + U_VT) + (size_t)((bl * 8 + h) * 64) * SEQ;
#pragma unroll
                            for (int i = 0; i < 4; ++i) { const int ch = tid + i * 512; const int key = ch >> 3, c = ch & 7; const int row = min(max(rowb + (key >> 6), 0), 63);
                                *(LAS u32x4*)(lds + NA_K_OFF + key * 144 + c * 16) = *(const u32x4*)(KNb + (size_t)(row * 64 + (key & 63)) * 512 + c * 8); }
#pragma unroll
                            for (int i = 0; i < 4; ++i) { const int ch = tid + i * 512; const int d = ch >> 5, krl = (ch >> 3) & 3, c = ch & 7; const int row = min(max(rowb + krl, 0), 63);
                                *(LAS u32x4*)(lds + NA_V_OFF + d * 528 + (krl * 64 + c * 8) * 2) = *(const u32x4*)(VTb + (size_t)d * SEQ + row * 64 + c * 8); }
                        }
                        __syncthreads();
#pragma unroll
                        for (int i = 0; i < 4; ++i) { const int grow = rw + i, r0 = min(max(grow - 4, 0), 56);
                            if (rowb + 3 >= r0 && rowb <= r0 + 7) {
                                na_block_lw(S4[i], ld16(Qp0 + (size_t)i * 64 * 512), ld16(Qp0 + (size_t)i * 64 * 512 + 32), lds + NA_K_OFF, lds + NA_V_OFF, rp + h * 15 * 31, rowb, grow, r0, kstart, qc, ws_, fr, fq); EPI_FENCE(); } }
                    }
#pragma unroll
                    for (int i = 0; i < 4; ++i) { const float inv = 1.f / S4[i].l; bf16* op = Aout + (size_t)(bl * SEQ + (rw + i) * 64 + cb * 16 + fr) * 512 + h * 64 + 4 * fq;
#pragma unroll
                        for (int dt = 0; dt < 4; ++dt) { u32x2 w; w.x = pk2(S4[i].o[dt][0] * inv, S4[i].o[dt][1] * inv); w.y = pk2(S4[i].o[dt][2] * inv, S4[i].o[dt][3] * inv); ST8(op + dt * 16, w); } }
                }
#endif
                const int n_pt = (with_ctx ? HROWS : LROWS) / 16, n_con = HB * 4 * 34 * 8;
#pragma unroll 1
                for (int rpc_ = 0; rpc_ < REP_PC; ++rpc_) {
#ifndef M1_NO_POOL
                    const bf16* PWp = (const bf16*)(wl + W_P); const float* psc = args.in[14] + l * 512;
#pragma unroll 1
                    for (int rpool_ = 0; rpool_ < REP_POOL; ++rpool_) {
#pragma unroll 1
                    for (int it = gw; it < n_pt; it += NGW) pool_item<3>(U, PWp, psc, Pout, it * 16, lane);
                    EPI_FENCE();
#pragma unroll 1
                    for (int it = (gw + NGW / 2) % NGW; it < n_pt; it += NGW) pool_item<2>(U, PWp, psc, Pout, it * 16, lane);
                    EPI_FENCE();
#pragma unroll 1
                    for (int it = (gw + NGW / 4) % NGW; it < n_pt; it += NGW) pool_item<1>(U, PWp, psc, Pout, it * 16, lane);
                    EPI_FENCE();
#pragma unroll 1
                    for (int it = (gw + 3 * NGW / 4) % NGW; it < n_pt; it += NGW) pool_item<0>(U, PWp, psc, Pout, it * 16, lane);
                    EPI_FENCE();
                    }
#endif
#ifndef M1_NO_CON
#pragma unroll 1
                    for (int bi = blockIdx.x; bi < HB * 4 * 34; bi += G) {
                        const int ch = bi % 34, bh = bi / 34, h = bh & 3, bl = bh >> 2; const bool ic = ch < 2; const int C = ic ? ch : ch - 2;
                        { const int row0 = (ic ? LROWS + bl * CTXL : bl * SEQ) + C * 128 + ((wave >> 1) & 1) * 64;
                            rope_item(U, RT, lg2_of_logit(args.in[10][l * 4 + h]), lg2_of_logit(args.in[11][l * 4 + h]), row0, h, wave & 1, wave >> 2, lane); }
                        asm volatile("s_waitcnt vmcnt(0)" ::: "memory");
                        __syncthreads();
                        contrib_item(U, (float*)(ws + WS_ST), bl, h, ic, C, wave, lane);
                    }
#endif
                }
                __syncthreads();
            }
            }
#endif
            PH_END
            PH_BEGIN
#ifndef OFF4
#pragma unroll 1
            for (int rep_ = 0; rep_ < REP4; ++rep_) {
            {
                const float* STp = (const float*)(ws + WS_ST); bf16* PV = (bf16*)(ws + WS_PREV);
                for (int idx = blockIdx.x * (NWAVES * 64) + tid; idx < 16 * 2 * 8192; idx += G * NWAVES * 64) {
                    const int e = idx & 8191, sd = idx >> 13, dir = sd & 1, h = (sd >> 1) & 3;
                    const float l2 = lg2_of_logit(dir == 0 ? args.in[10][l * 4 + h] : args.in[11][l * 4 + h]);
                    const float gC = exp2f(l2 * 128.f);
                    float s = 0.f; const size_t base = (size_t)sd * 34 * 8192 + e;
float cv[34];
#pragma unroll
                    for (int stp = 0; stp < 34; ++stp) cv[stp] = STp[base + (size_t)stp * 8192];
#pragma unroll
                    for (int stp = 0; stp < 34; ++stp) { PV[base + (size_t)stp * 8192] = bf1(s); s = s * gC + cv[stp]; }
                }
            }
            }
#endif
            PH_END
            PH_BEGIN
#ifndef OFF5
#pragma unroll 1
            for (int rep_ = 0; rep_ < REP5; ++rep_) {
            {
                bf16* Rout = (bf16*)(ws + WS_ARP + 17 * MiB);
                const int nch = with_ctx ? 34 : 32;
                const bf16* PREV = (const bf16*)(ws + WS_PREV);
                for (int bi = blockIdx.x; bi < 16 * nch; bi += G) {
                    int ch = bi % nch; const int bh = bi / nch; const int h = bh & 3, bl = bh >> 2;
                    bool ic = false; if (with_ctx) { ic = ch < 2; ch = ic ? ch : ch - 2; }
                    const int n = ic ? CTXL : SEQ; const int rowbase = ic ? (LROWS + bl * CTXL) : bl * SEQ;
                    const int stepf = ic ? ch : 2 + ch, stepb = ic ? 1 - ch : 2 + 31 - ch;
                    const bf16* KR = (const bf16*)(U + U_KR) + (size_t)(rowbase + ch * 128) * 256 + h * 64;
                    const bf16* VTR = (const bf16*)(U + (ic ? U_VTRC : U_VTR)) + (size_t)((bl * 4 + h) * 128) * n + ch * 128;
                    const bf16* Pf = PREV + ((size_t)(((bl * 4 + h) * 2 + 0) * 34 + stepf)) * 8192; const bf16* Pb = PREV + ((size_t)(((bl * 4 + h) * 2 + 1) * 34 + stepb)) * 8192;
                    __syncthreads();
#pragma unroll
                    for (int i = 0; i < 2; ++i) { const int cx = tid + i * 512; const int key = cx >> 3, c = cx & 7;
                        const int rho = (key & ~31) + 16 * ((key >> 2) & 1) + 4 * ((key >> 3) & 3) + (key & 3);
                        *(LAS u32x4*)(lds + RO_K + rho * 144 + c * 16) = *(const u32x4*)(KR + (size_t)key * 256 + c * 8);
                        *(LAS u32x4*)(lds + RO_PF + key * 144 + c * 16) = *(const u32x4*)(Pf + key * 64 + c * 8);
                        *(LAS u32x4*)(lds + RO_PB + key * 144 + c * 16) = *(const u32x4*)(Pb + key * 64 + c * 8); }
#pragma unroll
                    for (int i = 0; i < 4; ++i) { const int cx = tid + i * 512; const int dv = cx >> 4, c = cx & 15;
                        *(LAS u32x4*)(lds + RO_V + dv * 272 + c * 16) = *(const u32x4*)(VTR + (size_t)dv * n + c * 8); }
                    __syncthreads();
                    const float l2f = lg2_of_logit(args.in[10][l * 4 + h]), l2b = lg2_of_logit(args.in[11][l * 4 + h]);
                    retout_item(U, lds, Rout, args.in[12] + l * 512, l2f, l2b, bl, h, ic, ch, wave, lane);
                }
                __syncthreads();
            }
            }
#endif
            PH_END
            PH_BEGIN
#ifndef OFF6
#pragma unroll 1
            for (int rep_ = 0; rep_ < REP6; ++rep_) {
            {
                const int Mr = with_ctx ? HROWS : LROWS;
                pg8::Gemm gm{(const bf16*)(ws + WS_ARP), (const bf16*)(wl + W_BA), (long)(17 * MiB / 2), (long)(1 * MiB / 2), Mr, D, 512};
                pg8::ChainOrder S; S.S.init(Mr, D, G, (int)blockIdx.x);
                EpiMerge E{(const bf16*)(U + U_G), (bf16*)(ws + WS_XN + g * XN_HALF)};
                pg8::gemm_phase<EpiMerge, pg8::ChainOrder, ALIGN_SMALL, true>(lds, gm, S, E);
                if (g == 0 && with_ctx && (int)blockIdx.x >= 16) {
                    pg8::Gemm gi_{(const bf16*)(ws + WS_XN + XN_HALF), (const bf16*)(wl + W_IN), 0, (long)3584 * D, HROWS, INW, D};
                    pg8::InprojOrder SI; SI.SA.init(HROWS, 3584, 1, 0); SI.SB.init(HROWS, 3072, 1, 0); SI.lo = 0; SI.nA = IP_TAIL; SI.nB = 0; SI.G = G - 16; SI.c = (int)blockIdx.x - 16;
                    EpiInproj EI{U};
                    pg8::gemm_phase<EpiInproj, pg8::InprojOrder, true, true>(lds, gi_, SI, EI);
                }
                if (g == 1) {
                    const int skip = with_ctx ? 16 : 0;
                    if ((int)blockIdx.x >= skip) {
                        pg8::Gemm gw_{(const bf16*)(ws + WS_XN), (const bf16*)(wl + W_O), 0, 0, Mr, D, D};
                        pg8::StaticOrder SW; SW.init(Mr, D, G - skip, (int)blockIdx.x - skip);
                        EpiResid EW{hl, hcs, out, HC, modl + 2 * D, LROWS / 256, 0, 0};
                        pg8::gemm_phase<EpiResid, pg8::StaticOrder, ALIGN_SMALL, true>(lds, gw_, SW, EW);
                    }
                }
            }
            }
#endif
            PH_END
            }
        }
        const int Mf = with_ctx ? TROWS : TLAT;
        PH_BEGIN
#ifndef OFF8
#pragma unroll 1
            for (int rep_ = 0; rep_ < REP8; ++rep_) {
        for (int q = gw; q < (with_ctx ? HROWS : LROWS); q += NGW) {
            const int r = q < LROWS ? LROWS + q : TLAT + CROWS + (q - LROWS);
            const float* src; int bidx;
            if (r < TLAT) { src = out + (size_t)r * D; bidx = r >> 12; } else { src = HC + (size_t)(r - TLAT) * D; bidx = 8; }
            norm_row(src, (bf16*)(ws + WS_FX) + (size_t)r * D, args.in[5] + l * D, modl + bidx * NMODC + 3 * D, modl + bidx * NMODC + 4 * D, lane);
        }
            }
#endif
        PH_END
        PH_BEGIN
#ifndef OFF9
#pragma unroll 1
            for (int rep_ = 0; rep_ < REP9; ++rep_) {
        {
            pg8::Gemm gm{(const bf16*)(ws + WS_FX), (const bf16*)(wl + W_GU), 0, 0, Mf, 2 * FF, D};
            pg8::StaticOrder S; S.init(Mf, 2 * FF, G, (int)blockIdx.x);
            EpiFfn1 E{(bf16*)(ws + WS_HD)};
            pg8::gemm_phase<EpiFfn1, pg8::StaticOrder, true, true>(lds, gm, S, E);
        }
            }
#endif
        PH_END
        PH_BEGIN
#ifndef OFF10
#pragma unroll 1
            for (int rep_ = 0; rep_ < REP10; ++rep_) {
        {
            pg8::Gemm gm{(const bf16*)(ws + WS_HD), (const bf16*)(wl + W_D), 0, 0, Mf, D, FF};
            pg8::StaticOrder S; S.init(Mf, D, G, (int)blockIdx.x);
            EpiResid E{out, HC, out, HC, modl + 5 * D, TLAT / 256, 0, 0};
            pg8::gemm_phase<EpiResid, pg8::StaticOrder, ALIGN_SMALL, true>(lds, gm, S, E);
        }
            }
#endif
        PH_END
    }
    PH_BEGIN
#ifndef OFF11
#pragma unroll 1
            for (int rep_ = 0; rep_ < REP11; ++rep_) {
    for (int r = gw; r < TLAT; r += NGW) {
        float* p = out + (size_t)r * D; f32x4 v[4]; float ss = 0.f;
#pragma unroll
        for (int j = 0; j < 4; ++j) { v[j] = *(const f32x4*)(p + 4 * lane + 256 * j); ss += (v[j][0] * v[j][0] + v[j][1] * v[j][1]) + (v[j][2] * v[j][2] + v[j][3] * v[j][3]); }
        const float rstd = rsqrtf(wave_sum(ss) * (1.f / D) + 1e-6f);
#pragma unroll
        for (int j = 0; j < 4; ++j) { const int c = 4 * lane + 256 * j; *(f32x4*)(p + c) = v[j] * rstd * *(const f32x4*)(args.in[22] + c); }
    }
            }
#endif
    PH_END
#undef PH_BEGIN
#undef PH_END
}
constexpr int N_PHASES = 1 + 2 * (1 + 3 + 2 * 4 + 3) + 1;

extern "C" void kernel_launch(void* const* d_in, const int* in_sizes, int n_in, void* d_out, int out_size, void* d_ws, size_t ws_size, hipStream_t stream) {
    static int grid = 0;
    if (grid == 0) {
        if (n_in != 23 || in_sizes[0] != TLAT * D || out_size != TLAT * D || ws_size < WS_END) { fprintf(stderr, "kernel_launch: unexpected shapes / workspace (n_in %d, ws %zu)\n", n_in, ws_size); grid = -1; return; }
        int dev = 0, cus = 0, per_cu = 0;
        if (hipGetDevice(&dev) != hipSuccess || hipDeviceGetAttribute(&cus, hipDeviceAttributeMultiprocessorCount, dev) != hipSuccess) { grid = -1; return; }
        if (hipFuncSetAttribute((const void*)fwd_megakernel, hipFuncAttributeMaxDynamicSharedMemorySize, LDS_BYTES) != hipSuccess) { fprintf(stderr, "kernel_launch: hipFuncSetAttribute failed\n"); grid = -1; return; }
        if (hipOccupancyMaxActiveBlocksPerMultiprocessor(&per_cu, (const void*)fwd_megakernel, NWAVES * 64, LDS_BYTES) != hipSuccess || per_cu < 1) { fprintf(stderr, "kernel_launch: occupancy query says %d\n", per_cu); per_cu = 1; }
        (void)hipGetLastError();
        grid = cus * 1;
    }
    if (grid < 0) return;
    Args a{};
    for (int i = 0; i < 23; ++i) a.in[i] = (const float*)d_in[i];
    a.out = (float*)d_out; a.ws = (unsigned char*)d_ws;
#if MK_PER_PHASE
    for (int p = 0; p < N_PHASES; ++p) { a.ph_lo = p; a.ph_hi = p + 1; void* kargs[] = {&a};
        hipError_t e = hipLaunchCooperativeKernel((const void*)fwd_megakernel, dim3(grid), dim3(NWAVES * 64), kargs, LDS_BYTES, stream);
        if (e != hipSuccess) { fprintf(stderr, "launch %d failed: %s\n", p, hipGetErrorString(e)); break; } }
#else
    a.ph_lo = 0; a.ph_hi = N_PHASES;
    void* kargs[] = {&a};
    hipError_t e = hipLaunchCooperativeKernel((const void*)fwd_megakernel, dim3(grid), dim3(NWAVES * 64), kargs, LDS_BYTES, stream);
    if (e != hipSuccess) fprintf(stderr, "cooperative launch failed: %s (grid %d)\n", hipGetErrorString(e), grid);
#endif
}
```

```cpp
#include <hip/hip_runtime.h>
#include <hip/hip_cooperative_groups.h>
#include <cstdio>
#include <cstdint>
namespace cg = cooperative_groups;

#ifndef REP0
#define REP0 1
#endif
#ifndef REP1
#define REP1 1
#endif
#ifndef REP2
#define REP2 1
#endif
#ifndef REP3
#define REP3 1
#endif
#ifndef REP4
#define REP4 1
#endif
#ifndef REP5
#define REP5 1
#endif
#ifndef REP6
#define REP6 1
#endif
#ifndef REP7
#define REP7 1
#endif
#ifndef REP8
#define REP8 1
#endif
#ifndef REP9
#define REP9 1
#endif
#ifndef REP10
#define REP10 1
#endif
#ifndef REP11
#define REP11 1
#endif
#ifndef REP12
#define REP12 1
#endif
#ifndef REP_POOL
#define REP_POOL 1
#endif
#ifndef REP_CON
#define REP_CON 1
#endif
#ifndef REP_NA
#define REP_NA 1
#endif
#ifndef REP_PC
#define REP_PC 1
#endif
#ifndef NSYNC
#define NSYNC 1
#endif
#ifndef MK_PER_PHASE
#define MK_PER_PHASE 0
#endif

#ifndef PG8_WGM
#define PG8_WGM 8
#endif
namespace pg8 {
#define PG8_LAS __attribute__((address_space(3)))
typedef unsigned short bf16_t;
typedef short bf16x8 __attribute__((ext_vector_type(8)));
typedef float f32x4 __attribute__((ext_vector_type(4)));
typedef unsigned u32x4 __attribute__((ext_vector_type(4)));
constexpr int BM = 256, BK = 64, HALF = 128, HTB = HALF * BK * 2  , STAGE_BYTES = 8 * HTB, NXCD = 8, WGM = PG8_WGM;

__host__ __device__ __forceinline__ int lds_byte(int r, int c) { const int st = (r >> 4) * 2 + (c >> 5), rr = r & 15, cc = c & 31, ob = rr * 64 + cc * 2; return st * 1024 + (ob ^ (((ob >> 9) & 1) << 5)); }
__host__ __device__ __forceinline__ void stage_rc(int b, int& R, int& C) { const int st = b / 1024, sb = b % 1024, swz = sb ^ (((sb >> 9) & 1) << 5); R = (st >> 1) * 16 + swz / 64; C = (st & 1) * 32 + (swz % 64) / 2; }
__host__ __device__ __forceinline__ int perm32(int rho) { const int n = rho >> 4, i = rho & 15; return 8 * (i >> 2) + 4 * n + (i & 3); }

struct Unit { int pm, pn, sub; };
struct Gemm { const bf16_t* A; const bf16_t* Bt; long sa, sb; int M, N, K; };
__device__ __forceinline__ const bf16_t* selA(const Gemm& g, int s) { return g.A + (long)s * g.sa; }
__device__ __forceinline__ const bf16_t* selB(const Gemm& g, int s) { return g.Bt + (long)s * g.sb; }

struct StaticOrder {
    int nM, nN, nwg, G, c;
    __host__ __device__ __forceinline__ void init(int M, int N, int G_, int c_) { nM = M / BM; nN = N / BM; nwg = nM * nN; G = G_; c = c_; }
    __host__ __device__ __forceinline__ void map(int L, Unit& u) const {
        int wgid = L; { const int q = nwg / NXCD, r = nwg % NXCD, xcd = wgid % NXCD, off = wgid / NXCD; wgid = (xcd < r ? xcd * (q + 1) : r * (q + 1) + (xcd - r) * q) + off; }
        const int nig = WGM * nN, gid = wgid / nig, fm = gid * WGM, gsz = (nM - fm) < WGM ? (nM - fm) : WGM;
        u.pm = fm + ((wgid % nig) % gsz); u.pn = (wgid % nig) / gsz; u.sub = 0;
    }
    __host__ __device__ __forceinline__ bool next(int i, Unit& u) const {
        const long L = (long)i * G + c; if (L >= nwg) return false;
        map((int)L, u); return true;
    }
    __device__ __forceinline__ void a_ready(const Unit&) const {}
    __device__ __forceinline__ void done(const Unit&) const {}
};
struct InprojOrder {
    StaticOrder SA, SB; int lo, nA, nB, G, c;
    __device__ __forceinline__ bool next(int i, Unit& u) const {
        const int L = i * G + c;
        if (L < nA) { SA.map(lo + L, u); u.sub = 0; return true; }
        if (L - nA < nB) { SB.map(L - nA, u); u.sub = 1; return true; }
        return false;
    }
    __device__ __forceinline__ void a_ready(const Unit&) const {}
    __device__ __forceinline__ void done(const Unit&) const {}
};
struct ChainOrder {
    StaticOrder S;
    __device__ __forceinline__ bool next(int i, Unit& u) const { const int q = i / 3; if (!S.next(q, u)) return false; u.sub = i - 3 * q; return true; }
    __device__ __forceinline__ void a_ready(const Unit&) const {}
    __device__ __forceinline__ void done(const Unit&) const {}
};
__device__ __forceinline__ unsigned cvt_pk_bf16(float lo, float hi) { unsigned r; asm volatile("v_cvt_pk_bf16_f32 %0, %1, %2" : "=v"(r) : "v"(lo), "v"(hi)); return r; }

template <class Epi, class Sched, bool ALIGN_EPI = false, bool SP2 = false>
__device__ __forceinline__ void gemm_phase(PG8_LAS unsigned char* lds, const Gemm g, const Sched& S, const Epi& E) {
    int tid_raw = threadIdx.x; asm volatile("" : "+v"(tid_raw)); const int tid = tid_raw, wid = __builtin_amdgcn_readfirstlane(tid >> 6), lane = tid & 63, wr = wid >> 2, wc = wid & 3, fr = lane & 15, fq = lane >> 4;
    const int K = g.K, nt = K / BK;
    unsigned voffA[2], voffB[2];
#pragma unroll
    for (int i = 0; i < 2; ++i) { int R, C; stage_rc(tid * 16 + i * 8192, R, C); const int Rb = Epi::PERM ? ((R & ~31) + perm32(R & 31)) : R;
        voffA[i] = (unsigned)(R * K + C) * 2u; voffB[i] = (unsigned)(Rb * K + C) * 2u; }
    const size_t kstep = (size_t)(BK * 2);
    const size_t hstep = (size_t)HALF * K * 2;
    const size_t tstep = 2 * hstep;
    const unsigned ldsw = (unsigned)wid * 1024u;
    const int aoff = lds_byte(wr * 64 + fr, fq * 8), boff = lds_byte(wc * 32 + fr, fq * 8);
#define PG8_SA(b, h) (((b) * 2 + (h)) * HTB)
#define PG8_SB(b, h) ((4 + (b) * 2 + (h)) * HTB)
#define PG8_STAGE(bufoff, gbase, voff) do { _Pragma("unroll") for (int _i = 0; _i < 2; ++_i) \
        __builtin_amdgcn_global_load_lds((const unsigned*)((const char*)(gbase) + (voff)[_i]), (PG8_LAS unsigned*)(lds + (bufoff) + ldsw + _i * 8192), 16, 0, 0); } while (0)
#define PG8_LDA(dst, b, h) do { _Pragma("unroll") for (int m = 0; m < 4; ++m) _Pragma("unroll") for (int k = 0; k < 2; ++k) dst[m][k] = *(const PG8_LAS bf16x8*)(lds + PG8_SA(b, h) + aoff + m * 2048 + k * 1024); } while (0)
#define PG8_LDB(dst, b, h) do { _Pragma("unroll") for (int n = 0; n < 2; ++n) _Pragma("unroll") for (int k = 0; k < 2; ++k) dst[n][k] = *(const PG8_LAS bf16x8*)(lds + PG8_SB(b, h) + boff + n * 2048 + k * 1024); } while (0)
#define PG8_MMA(ai, bj, At, Bt) do { __builtin_amdgcn_s_setprio(1); _Pragma("unroll") for (int m = 0; m < 4; ++m) _Pragma("unroll") for (int n = 0; n < 2; ++n) _Pragma("unroll") for (int k = 0; k < 2; ++k) \
        acc[ai][bj][m][n] = __builtin_amdgcn_mfma_f32_16x16x32_bf16(Bt[n][k], At[m][k], acc[ai][bj][m][n], 0, 0, 0); __builtin_amdgcn_s_setprio(0); } while (0)
#define PG8_WAIT_V(n) asm volatile("s_waitcnt vmcnt(" #n ")" ::: "memory")
#define PG8_WAIT_L(n) asm volatile("s_waitcnt lgkmcnt(" #n ")" ::: "memory")
#define PG8_BAR __builtin_amdgcn_s_barrier()
#define PG8_SCHED __builtin_amdgcn_sched_barrier(0)
    Unit cur, nxt; int ui = 0;
    if (!S.next(0, cur)) return;
    f32x4 acc[2][2][4][2];
#pragma unroll
    for (int a = 0; a < 2; ++a)
#pragma unroll
        for (int b = 0; b < 2; ++b)
#pragma unroll
            for (int m = 0; m < 4; ++m)
#pragma unroll
                for (int n = 0; n < 2; ++n) acc[a][b][m][n] = (f32x4){0.f, 0.f, 0.f, 0.f};
    bf16x8 At[4][2], B0[2][2], B1[2][2];
    const char* cA = (const char*)selA(g, cur.sub) + (size_t)cur.pm * tstep; const char* cB = (const char*)selB(g, cur.sub) + (size_t)cur.pn * tstep;
    S.a_ready(cur);
    if constexpr (SP2) {
        PG8_STAGE(PG8_SB(0, 0), cB, voffB); PG8_STAGE(PG8_SB(0, 1), cB + hstep, voffB); PG8_STAGE(PG8_SA(0, 0), cA, voffA); PG8_STAGE(PG8_SA(0, 1), cA + hstep, voffA);
        if (wr == 1) PG8_BAR;
        PG8_WAIT_V(2); PG8_BAR;
        PG8_STAGE(PG8_SB(1, 0), cB + kstep, voffB); PG8_STAGE(PG8_SA(1, 0), cA + kstep, voffA); PG8_STAGE(PG8_SB(1, 1), cB + hstep + kstep, voffB);
        PG8_WAIT_V(6); PG8_BAR;
    } else {
        PG8_STAGE(PG8_SB(0, 0), cB, voffB); PG8_STAGE(PG8_SA(0, 0), cA, voffA); PG8_STAGE(PG8_SB(0, 1), cB + hstep, voffB); PG8_STAGE(PG8_SA(0, 1), cA + hstep, voffA);
        if (wr == 1) PG8_BAR;
        PG8_WAIT_V(4); PG8_BAR;
        PG8_STAGE(PG8_SB(1, 0), cB + kstep, voffB); PG8_STAGE(PG8_SA(1, 0), cA + kstep, voffA); PG8_STAGE(PG8_SB(1, 1), cB + hstep + kstep, voffB);
        PG8_WAIT_V(6); PG8_BAR;
    }
    for (;;) {
        const bool has_next = S.next(ui + 1, nxt);
        const char* nA = has_next ? (const char*)selA(g, nxt.sub) + (size_t)nxt.pm * tstep : cA; const char* nB = has_next ? (const char*)selB(g, nxt.sub) + (size_t)nxt.pn * tstep : cB;
        for (int t = 0; t < nt; t += 2) {
            const bool last = (t == nt - 2);
            const char* a1 = cA + (size_t)(t + 1) * kstep;
            const char* a2 = last ? nA : cA + (size_t)(t + 2) * kstep; const char* b2 = last ? nB : cB + (size_t)(t + 2) * kstep;
            const char* a3 = a2 + kstep; const char* b3 = b2 + kstep;
            if (last && has_next) S.a_ready(nxt);
            if constexpr (SP2) {
            PG8_LDB(B0, 0, 0); PG8_LDB(B1, 0, 1); PG8_SCHED; PG8_LDA(At, 0, 0); PG8_STAGE(PG8_SA(1, 1), a1 + hstep, voffA);
            PG8_WAIT_V(8); PG8_WAIT_L(0); PG8_BAR; PG8_MMA(0, 0, At, B0); PG8_MMA(0, 1, At, B1); PG8_BAR; PG8_SCHED;
            PG8_LDA(At, 0, 1); PG8_STAGE(PG8_SB(0, 0), b2, voffB); PG8_STAGE(PG8_SB(0, 1), b2 + hstep, voffB); PG8_STAGE(PG8_SA(0, 0), a2, voffA);
            PG8_WAIT_V(8); PG8_WAIT_L(0); PG8_BAR; PG8_MMA(1, 0, At, B0); PG8_MMA(1, 1, At, B1); PG8_BAR; PG8_SCHED;
            PG8_LDB(B0, 1, 0); PG8_LDB(B1, 1, 1); PG8_SCHED; PG8_LDA(At, 1, 0); PG8_STAGE(PG8_SA(0, 1), a2 + hstep, voffA);
            PG8_WAIT_V(8); PG8_WAIT_L(0); PG8_BAR; PG8_MMA(0, 0, At, B0); PG8_MMA(0, 1, At, B1); PG8_BAR; PG8_SCHED;
            PG8_LDA(At, 1, 1); PG8_STAGE(PG8_SB(1, 0), b3, voffB); PG8_STAGE(PG8_SB(1, 1), b3 + hstep, voffB); PG8_STAGE(PG8_SA(1, 0), a3, voffA);
            PG8_WAIT_V(8); PG8_WAIT_L(0); PG8_BAR; PG8_MMA(1, 0, At, B0); PG8_MMA(1, 1, At, B1); PG8_BAR; PG8_SCHED;
            } else {
            PG8_LDB(B0, 0, 0); PG8_SCHED; PG8_LDA(At, 0, 0); PG8_STAGE(PG8_SA(1, 1), a1 + hstep, voffA);
            PG8_WAIT_L(8); PG8_BAR; PG8_WAIT_L(0); PG8_MMA(0, 0, At, B0); PG8_BAR; PG8_SCHED;
            PG8_LDB(B1, 0, 1); PG8_STAGE(PG8_SB(0, 0), b2, voffB);
            PG8_BAR; PG8_WAIT_L(0); PG8_MMA(0, 1, At, B1); PG8_BAR;
            PG8_LDA(At, 0, 1); PG8_STAGE(PG8_SA(0, 0), a2, voffA);
            PG8_BAR; PG8_WAIT_L(0); PG8_MMA(1, 0, At, B0); PG8_BAR; PG8_SCHED;
            PG8_STAGE(PG8_SB(0, 1), b2 + hstep, voffB);
            PG8_WAIT_V(6); PG8_BAR; PG8_MMA(1, 1, At, B1); PG8_BAR;
            PG8_LDB(B0, 1, 0); PG8_SCHED; PG8_LDA(At, 1, 0); PG8_STAGE(PG8_SA(0, 1), a2 + hstep, voffA);
            PG8_WAIT_L(8); PG8_BAR; PG8_WAIT_L(0); PG8_MMA(0, 0, At, B0); PG8_BAR; PG8_SCHED;
            PG8_LDB(B1, 1, 1); PG8_STAGE(PG8_SB(1, 0), b3, voffB);
            PG8_BAR; PG8_WAIT_L(0); PG8_MMA(0, 1, At, B1); PG8_BAR;
            PG8_LDA(At, 1, 1); PG8_STAGE(PG8_SA(1, 0), a3, voffA);
            PG8_BAR; PG8_WAIT_L(0); PG8_MMA(1, 0, At, B0); PG8_BAR; PG8_SCHED;
            PG8_STAGE(PG8_SB(1, 1), b3 + hstep, voffB);
            PG8_WAIT_V(6); PG8_BAR; PG8_MMA(1, 1, At, B1); PG8_BAR;
            }
        }
        if constexpr (ALIGN_EPI) { if (wr == 0) PG8_BAR; }
        if constexpr (!Epi::AFTER_DRAIN) { E(acc, cur, wr, wc, fr, fq); S.done(cur); }
        if (!has_next) break;
        if (!(Epi::CHAIN && nxt.sub != 0))
#pragma unroll
        for (int a = 0; a < 2; ++a)
#pragma unroll
            for (int b = 0; b < 2; ++b)
#pragma unroll
                for (int m = 0; m < 4; ++m)
#pragma unroll
                    for (int n = 0; n < 2; ++n) acc[a][b][m][n] = (f32x4){0.f, 0.f, 0.f, 0.f};
        cur = nxt; cA = nA; cB = nB; ++ui;
        if constexpr (ALIGN_EPI) { if (wr == 1) PG8_BAR; }
    }
    PG8_WAIT_V(0);
    if constexpr (!ALIGN_EPI) { if (wr == 0) PG8_BAR; }
    PG8_BAR;
    if constexpr (Epi::AFTER_DRAIN) { E.fused(acc, cur, wr, wc, fr, fq, lds, wid, lane); S.done(cur); }
#undef PG8_SA
#undef PG8_SB
#undef PG8_STAGE
#undef PG8_LDA
#undef PG8_LDB
#undef PG8_MMA
#undef PG8_WAIT_V
#undef PG8_WAIT_L
#undef PG8_BAR
#undef PG8_SCHED
}

}

constexpr int NWAVES = 8;
constexpr int D = 1024, NBATCH = 8, SEQ = 4096, CTXL = 256, INW = 6656, FF = 2816;
constexpr int HB = 4;
constexpr int LROWS = HB * SEQ, CROWS = HB * CTXL, HROWS = LROWS + CROWS;
constexpr int TLAT = NBATCH * SEQ, TCTX = NBATCH * CTXL, TROWS = TLAT + TCTX;
constexpr int NMODC = 6 * D;

constexpr size_t MiB = 1u << 20;
constexpr size_t WS_BAR = 16 * 1024;
constexpr size_t WS_MOD = 64 * 1024;
constexpr size_t WS_RT = 512 * 1024;
constexpr size_t WS_W = 1 * MiB, WL_STRIDE = 35 * MiB;
constexpr size_t W_IN = 0, W_BA = 13 * MiB, W_BB = 14 * MiB, W_BC = 15 * MiB, W_O = 16 * MiB, W_GU = 18 * MiB, W_D = 29 * MiB, W_P = 34 * MiB + 512 * 1024;
constexpr size_t WS_HC = 71 * MiB;
constexpr size_t WS_XN = 79 * MiB;
constexpr size_t WS_U = 147 * MiB;
constexpr size_t U_QN = 0, U_KN = 17 * MiB, U_VT = 34 * MiB, U_VTC = 50 * MiB, U_QR = 51 * MiB, U_KR = 59 * MiB + 512 * 1024, U_KTF = 68 * MiB, U_KTFC = 76 * MiB,
                 U_KTB = 76 * MiB + 512 * 1024, U_KTBC = 84 * MiB + 512 * 1024, U_VTR = 85 * MiB, U_VTRC = 101 * MiB, U_GR = 102 * MiB, U_UP = 119 * MiB, U_G = 136 * MiB;
constexpr size_t WS_ARP = 385 * MiB;
constexpr size_t WS_ST = 436 * MiB, WS_PREV = 470 * MiB, WS_END = 487 * MiB;
constexpr size_t XN_HALF = 34 * MiB;
constexpr size_t WS_FX = WS_ARP;
constexpr size_t WS_HD = WS_U;

constexpr int IP_TAIL = 240;
constexpr int LDS_BYTES = 131072 + 1024;

#define LAS __attribute__((address_space(3)))
typedef unsigned short bf16;
typedef short bf16x8 __attribute__((ext_vector_type(8)));
typedef float f32x4 __attribute__((ext_vector_type(4)));
typedef float f32x2 __attribute__((ext_vector_type(2)));
typedef unsigned u32x4 __attribute__((ext_vector_type(4)));
typedef unsigned u32x2 __attribute__((ext_vector_type(2)));
#ifndef ALIGN_SMALL
#define ALIGN_SMALL true
#endif
#ifndef WT8
#define WT8 0
#endif
#if WT8
#define ST8(p, w) __hip_atomic_store((unsigned long long*)(p), __builtin_bit_cast(unsigned long long, (w)), __ATOMIC_RELAXED, __HIP_MEMORY_SCOPE_AGENT)
#else
#define ST8(p, w) (*(u32x2*)(p) = (w))
#endif
#define MMA16(a, b, c) __builtin_amdgcn_mfma_f32_16x16x32_bf16(a, b, c, 0, 0, 0)
#define LOG2E 1.4426950408889634f

__device__ __forceinline__ unsigned pk2(float lo, float hi) { return pg8::cvt_pk_bf16(lo, hi); }
__device__ __forceinline__ float bflo(unsigned w) { return __uint_as_float(w << 16); }
__device__ __forceinline__ float bfhi(unsigned w) { return __uint_as_float(w & 0xffff0000u); }
__device__ __forceinline__ bf16x8 ld16(const bf16* p) { return *(const bf16x8*)p; }
__device__ __forceinline__ unsigned short bf1(float v) { return (unsigned short)(pk2(v, 0.f) & 0xffffu); }
__device__ __forceinline__ float wave_sum(float v) {
#pragma unroll
    for (int o = 1; o < 64; o <<= 1) v += __shfl_xor(v, o);
    return v;
}
__device__ __forceinline__ float lg2_of_logit(float logit) { return -log1pf(expf(-logit)) * LOG2E; }
__device__ __forceinline__ float enx(float g) { return __builtin_amdgcn_exp2f(__builtin_amdgcn_fmed3f(g, -30.f, 30.f) * -LOG2E); }
__device__ __forceinline__ float sigm(float g) { return __builtin_amdgcn_rcpf(1.f + enx(g)); }
__device__ __forceinline__ float sigratio(float a, float b) { return (1.f + enx(b)) * __builtin_amdgcn_rcpf(1.f + enx(a)); }

__device__ __forceinline__ float dppx1(float v) { return __builtin_bit_cast(float, __builtin_amdgcn_mov_dpp(__builtin_bit_cast(int, v), 0xB1, 0xF, 0xF, true)); }
__device__ __forceinline__ float dppx2(float v) { return __builtin_bit_cast(float, __builtin_amdgcn_mov_dpp(__builtin_bit_cast(int, v), 0x4E, 0xF, 0xF, true)); }
__device__ __forceinline__ f32x4 quad_transpose(f32x4 v, bool b0, bool b1) {
    const float r0 = dppx1(b0 ? v[0] : v[1]), r1 = dppx1(b0 ? v[2] : v[3]);
    const float x0 = b0 ? r0 : v[0], x1 = b0 ? v[1] : r0, x2 = b0 ? r1 : v[2], x3 = b0 ? v[3] : r1;
    const float q0 = dppx2(b1 ? x0 : x2), q1 = dppx2(b1 ? x1 : x3);
    f32x4 w; w[0] = b1 ? q0 : x0; w[1] = b1 ? q1 : x1; w[2] = b1 ? x2 : q0; w[3] = b1 ? x3 : q1; return w;
}

struct EpiInproj {
    static constexpr bool PERM = false, AFTER_DRAIN = false, CHAIN = false;
    unsigned char* U;
#define EPI_FENCE() asm volatile("" ::: "memory")
    __device__ __forceinline__ void operator()(f32x4 (&acc)[2][2][4][2], const pg8::Unit& u, int wr, int wc, int fr, int fq) const {
        const int pn = u.pn + (u.sub ? 14 : 0);
        const bool isctx = u.pm >= 64;
        const int bl = isctx ? (u.pm - 64) : (u.pm >> 4);
        const int nseq = isctx ? CTXL : SEQ;
        const int tb = (isctx ? 0 : ((u.pm & 15) * 256)) + wr * 64 + fr;
        const int rbase = u.pm * 256 + wr * 64 + fr;
        if (pn < 4 || pn >= 10) {
            bf16* dst; int ld = 512, c0;
            if (pn < 2) { dst = (bf16*)(U + U_QN); c0 = pn * 256; }
            else if (pn < 4) { dst = (bf16*)(U + U_KN); c0 = (pn - 2) * 256; }
            else if (pn < 12) { dst = (bf16*)(U + U_GR); c0 = (pn - 10) * 256; }
            else if (pn < 14) { dst = (bf16*)(U + U_UP); c0 = (pn - 12) * 256; }
            else { dst = (bf16*)(U + U_G); c0 = (pn - 14) * 256; ld = 3072; }
            bf16* rp0 = dst + (size_t)rbase * ld + c0 + wc * 32 + fq * 4;
#pragma unroll
            for (int ai = 0; ai < 2; ++ai)
#pragma unroll
                for (int m = 0; m < 4; ++m) { bf16* rp = rp0 + (size_t)(ai * 128 + m * 16) * ld;
#pragma unroll
                    for (int bj = 0; bj < 2; ++bj)
#pragma unroll
                        for (int n = 0; n < 2; ++n) { f32x4 v = acc[ai][bj][m][n]; if (pn >= 14) { v[0] = sigm(v[0]); v[1] = sigm(v[1]); v[2] = sigm(v[2]); v[3] = sigm(v[3]); }
                            u32x2 w; w.x = pk2(v[0], v[1]); w.y = pk2(v[2], v[3]); ST8(rp + bj * 128 + n * 16, w); }
                    EPI_FENCE(); }
        } else if (pn < 6 || pn >= 8) {
            const bool nav = pn < 6;
            bf16* dst = (bf16*)(U + (nav ? (isctx ? U_VTC : U_VT) : (isctx ? U_VTRC : U_VTR)));
            const int ccb = (nav ? (pn - 4) : (pn - 8)) * 256 + wc * 32 + fq * 4 + (fr & 3);
            const bool b0 = (fr & 1) != 0, b1 = (fr & 2) != 0;
            bf16* bp0 = dst + (size_t)(bl * 512 + ccb) * nseq + (tb - fr) + 4 * (fr >> 2);
#pragma unroll
            for (int bj = 0; bj < 2; ++bj)
#pragma unroll
                for (int n = 0; n < 2; ++n) { bf16* bp = bp0 + (size_t)(bj * 128 + n * 16) * nseq;
#pragma unroll
                    for (int ai = 0; ai < 2; ++ai)
#pragma unroll
                        for (int m = 0; m < 4; ++m) { const f32x4 w4 = quad_transpose(acc[ai][bj][m][n], b0, b1); u32x2 w; w.x = pk2(w4[0], w4[1]); w.y = pk2(w4[2], w4[3]); *(u32x2*)(bp + ai * 128 + m * 16) = w; }
                    EPI_FENCE(); }
        }
        else {
            bf16* rp0 = (bf16*)(U + (pn == 6 ? U_QR : U_KR)) + (size_t)rbase * 256 + wc * 32 + fq * 4;
#pragma unroll
            for (int ai = 0; ai < 2; ++ai)
#pragma unroll
                for (int m = 0; m < 4; ++m) { bf16* rp = rp0 + (size_t)(ai * 128 + m * 16) * 256;
#pragma unroll
                    for (int bj = 0; bj < 2; ++bj)
#pragma unroll
                        for (int n = 0; n < 2; ++n) { const f32x4 v = acc[ai][bj][m][n]; u32x2 w; w.x = pk2(v[0], v[1]); w.y = pk2(v[2], v[3]); ST8(rp + bj * 128 + n * 16, w); }
                    EPI_FENCE(); }
        }
    }
};

struct EpiNull { static constexpr bool PERM = false, AFTER_DRAIN = false, CHAIN = false; float* sink;
    __device__ __forceinline__ void operator()(f32x4 (&acc)[2][2][4][2], const pg8::Unit& u, int wr, int wc, int fr, int fq) const { f32x4 s = {0.f, 0.f, 0.f, 0.f};
#pragma unroll
        for (int a = 0; a < 2; ++a)
#pragma unroll
            for (int b = 0; b < 2; ++b)
#pragma unroll
                for (int m = 0; m < 4; ++m)
#pragma unroll
                    for (int n = 0; n < 2; ++n) s += acc[a][b][m][n];
        if (s[0] + s[1] + s[2] + s[3] == 1.2345e-33f) sink[0] = 1.f; } };

struct EpiMerge {
    static constexpr bool PERM = false, AFTER_DRAIN = false, CHAIN = true;
    const bf16* G; bf16* Mo;
    __device__ __forceinline__ void operator()(f32x4 (&acc)[2][2][4][2], const pg8::Unit& u, int wr, int wc, int fr, int fq) const {
        const int rbase = u.pm * 256 + wr * 64 + fr, c0 = u.pn * 256 + wc * 32 + fq * 4, sub = u.sub;
#pragma unroll
        for (int ai = 0; ai < 2; ++ai)
#pragma unroll
            for (int m = 0; m < 4; ++m) { const size_t row = (size_t)(rbase + ai * 128 + m * 16); const bf16* gp = G + row * 3072 + c0;
#pragma unroll
                for (int bj = 0; bj < 2; ++bj)
#pragma unroll
                    for (int n = 0; n < 2; ++n) { const int co = bj * 128 + n * 16; f32x4 v = acc[ai][bj][m][n];
                        if (sub < 2) { const u32x2 a = *(const u32x2*)(gp + sub * 1024 + co), b = *(const u32x2*)(gp + (sub + 1) * 1024 + co);
                            v[0] *= bflo(a.x) * __builtin_amdgcn_rcpf(bflo(b.x)); v[1] *= bfhi(a.x) * __builtin_amdgcn_rcpf(bfhi(b.x)); v[2] *= bflo(a.y) * __builtin_amdgcn_rcpf(bflo(b.y)); v[3] *= bfhi(a.y) * __builtin_amdgcn_rcpf(bfhi(b.y));
                            acc[ai][bj][m][n] = v; }
                        else { const u32x2 a = *(const u32x2*)(gp + 2048 + co);
                            v[0] *= bflo(a.x); v[1] *= bfhi(a.x); v[2] *= bflo(a.y); v[3] *= bfhi(a.y);
                            u32x2 w; w.x = pk2(v[0], v[1]); w.y = pk2(v[2], v[3]); ST8(Mo + row * 1024 + c0 + co, w); } } }
    }
};

struct EpiResid {
    static constexpr bool PERM = false, AFTER_DRAIN = false, CHAIN = false;
    const float* base_lat; const float* base_ctx; float* out_lat; float* out_ctx; const float* mod; int lat_tiles, off_lat, off_ctx;
    __device__ __forceinline__ void operator()(f32x4 (&acc)[2][2][4][2], const pg8::Unit& u, int wr, int wc, int fr, int fq) const {
        const bool isctx = u.pm >= lat_tiles;
        const int r0 = (isctx ? off_ctx + (u.pm - lat_tiles) * 256 : off_lat + u.pm * 256);
        const int bidx = isctx ? 8 : (r0 >> 12);
        const float* bp = isctx ? base_ctx : base_lat; float* op = isctx ? out_ctx : out_lat;
        const int c0 = u.pn * 256 + wc * 32 + fq * 4;
        f32x4 mv[2][2];
#pragma unroll
        for (int bj = 0; bj < 2; ++bj)
#pragma unroll
            for (int n = 0; n < 2; ++n) mv[bj][n] = *(const f32x4*)(mod + bidx * NMODC + c0 + bj * 128 + n * 16);
#pragma unroll
        for (int ai = 0; ai < 2; ++ai)
#pragma unroll
            for (int m = 0; m < 4; ++m) { const size_t off = (size_t)(r0 + wr * 64 + fr + ai * 128 + m * 16) * D + c0;
#pragma unroll
                for (int bj = 0; bj < 2; ++bj)
#pragma unroll
                    for (int n = 0; n < 2; ++n) { const f32x4 b = *(const f32x4*)(bp + off + bj * 128 + n * 16); *(f32x4*)(op + off + bj * 128 + n * 16) = b + mv[bj][n] * acc[ai][bj][m][n]; } }
    }
};

struct EpiFfn1 {
    static constexpr bool PERM = false, AFTER_DRAIN = false, CHAIN = false;
    bf16* Hd;
    __device__ __forceinline__ void operator()(f32x4 (&acc)[2][2][4][2], const pg8::Unit& u, int wr, int wc, int fr, int fq) const {
        const int rbase = u.pm * 256 + wr * 64 + fr;
#pragma unroll
        for (int ai = 0; ai < 2; ++ai)
#pragma unroll
            for (int m = 0; m < 4; ++m) { bf16* rp = Hd + (size_t)(rbase + ai * 128 + m * 16) * FF + (u.pn * 256 + wc * 32) / 2 + fq * 4;
#pragma unroll
                for (int bj = 0; bj < 2; ++bj) { const f32x4 g = acc[ai][bj][m][0], up = acc[ai][bj][m][1]; f32x4 h;
#pragma unroll
                    for (int j = 0; j < 4; ++j) h[j] = g[j] * sigm(g[j]) * up[j];
                    u32x2 w; w.x = pk2(h[0], h[1]); w.y = pk2(h[2], h[3]); ST8(rp + bj * 64, w); } }
    }
};

struct Args { const float* in[23]; float* out; unsigned char* ws; int ph_lo, ph_hi; };

__device__ __forceinline__ void transpose_item(const float* W, int K, int N, bf16* WT, int mode, LAS float* scr, int item, int lane) {
    const int nblk = N / 32, kb = item / nblk, nb = item % nblk, k0 = 64 * kb, n0 = 32 * nb;
#pragma unroll 8
    for (int i = 0; i < 32; ++i) { const int kk = 2 * i + (lane >> 5); scr[kk * 33 + (lane & 31)] = W[(size_t)(k0 + kk) * N + n0 + (lane & 31)]; }
    asm volatile("s_waitcnt lgkmcnt(0)" ::: "memory");
    const int c = lane & 7;
#pragma unroll
    for (int j = 0; j < 4; ++j) { const int n = (lane >> 3) + 8 * j; const LAS float* s = scr + (8 * c) * 33 + n;
        u32x4 o; o.x = pk2(s[0 * 33], s[1 * 33]); o.y = pk2(s[2 * 33], s[3 * 33]); o.z = pk2(s[4 * 33], s[5 * 33]); o.w = pk2(s[6 * 33], s[7 * 33]);
        const int nn = n0 + n; const int dr = (mode == 0) ? nn : (nn + 16 * (nn >> 4) + (mode == 2 ? 16 : 0));
        *(u32x4*)(WT + (size_t)dr * K + k0 + 8 * c) = o; }
    asm volatile("s_waitcnt lgkmcnt(0)" ::: "memory");
}

__device__ __forceinline__ void norm_row(const float* src, bf16* dst, const float* gam, const float* shift, const float* scale, int lane) {
    f32x4 v[4]; float ss = 0.f;
#pragma unroll
    for (int j = 0; j < 4; ++j) { v[j] = *(const f32x4*)(src + 4 * lane + 256 * j); ss += (v[j][0] * v[j][0] + v[j][1] * v[j][1]) + (v[j][2] * v[j][2] + v[j][3] * v[j][3]); }
    const float rstd = rsqrtf(wave_sum(ss) * (1.f / D) + 1e-6f);
#pragma unroll
    for (int j = 0; j < 4; ++j) { const int c = 4 * lane + 256 * j; const f32x4 g = *(const f32x4*)(gam + c), sh = *(const f32x4*)(shift + c), sc = *(const f32x4*)(scale + c);
        const f32x4 y = (v[j] * rstd * g) * (sc + 1.0f) + sh; u32x2 w; w.x = pk2(y[0], y[1]); w.y = pk2(y[2], y[3]); ST8(dst + c, w); }
}

__device__ __forceinline__ void rope_item(unsigned char* U, const float* RT, float l2f, float l2b, int row0, int h, int which, int hf0, int lane) {
    const bool isctx = row0 >= LROWS;
    const int row = row0 + lane;
    bf16* p = (bf16*)(U + (which == 0 ? U_QR : U_KR)) + (size_t)row * 256 + h * 64;
    int t, bl, n; if (!isctx) { t = row & (SEQ - 1); bl = row >> 12; n = SEQ; } else { t = (row - LROWS) & (CTXL - 1); bl = (row - LROWS) >> 8; n = CTXL; }
    const int prow = isctx ? 0 : (t >> 6), pcol = isctx ? 0 : (t & 63);
    const float sc = which == 0 ? 1.0f : 0.125f;
    const int pc = t & 127; const float wf = __builtin_amdgcn_exp2f(l2f * (float)(127 - pc)), wb = __builtin_amdgcn_exp2f(l2b * (float)pc);
    bf16* kf = (bf16*)(U + (isctx ? U_KTFC : U_KTF)) + (size_t)((bl * 4 + h) * 64) * n + t;
    bf16* kb = (bf16*)(U + (isctx ? U_KTBC : U_KTB)) + (size_t)((bl * 4 + h) * 64) * n + t;
    { const int hf = hf0;
        const int pos = hf == 0 ? prow : pcol;
        u32x4 w0 = *(const u32x4*)(p + hf * 32), w1 = *(const u32x4*)(p + hf * 32 + 8), w2 = *(const u32x4*)(p + hf * 32 + 16), w3 = *(const u32x4*)(p + hf * 32 + 24);
        float x1[16], x2[16];
#pragma unroll
        for (int i = 0; i < 4; ++i) { x1[2 * i] = bflo(w0[i]); x1[2 * i + 1] = bfhi(w0[i]); x1[8 + 2 * i] = bflo(w1[i]); x1[8 + 2 * i + 1] = bfhi(w1[i]);
            x2[2 * i] = bflo(w2[i]); x2[2 * i + 1] = bfhi(w2[i]); x2[8 + 2 * i] = bflo(w3[i]); x2[8 + 2 * i + 1] = bfhi(w3[i]); }
#pragma unroll
        for (int i = 0; i < 16; ++i) { const f32x2 cs = *(const f32x2*)(RT + (pos * 16 + i) * 2); const float a = x1[i], b = x2[i];
            x1[i] = (a * cs[0] - b * cs[1]) * sc; x2[i] = (a * cs[1] + b * cs[0]) * sc; }
#pragma unroll
        for (int i = 0; i < 4; ++i) { w0[i] = pk2(x1[2 * i], x1[2 * i + 1]); w1[i] = pk2(x1[8 + 2 * i], x1[8 + 2 * i + 1]); w2[i] = pk2(x2[2 * i], x2[2 * i + 1]); w3[i] = pk2(x2[8 + 2 * i], x2[8 + 2 * i + 1]); }
        *(u32x4*)(p + hf * 32) = w0; *(u32x4*)(p + hf * 32 + 8) = w1; *(u32x4*)(p + hf * 32 + 16) = w2; *(u32x4*)(p + hf * 32 + 24) = w3;
        if (which == 1) {
#pragma unroll
            for (int i = 0; i < 16; ++i) { kf[(size_t)(hf * 32 + i) * n] = bf1(x1[i] * wf); kb[(size_t)(hf * 32 + i) * n] = bf1(x1[i] * wb);
                kf[(size_t)(hf * 32 + 16 + i) * n] = bf1(x2[i] * wf); kb[(size_t)(hf * 32 + 16 + i) * n] = bf1(x2[i] * wb); }
        }
        EPI_FENCE();
    }
}

struct NaState { f32x4 o[4]; float mrun, l; };
template <bool ISW>
__device__ __forceinline__ void na_block(NaState& S, const bf16x8 q0, const bf16x8 q1, const bf16* Kp0, const bf16* vb, const LAS unsigned char* kl, const LAS unsigned char* vl,
                                         const LAS float* rp0, int kstart, int qc, int ws_, int fq) {
    f32x4 st[8];
    bf16x8 vw[16];
    if (ISW) {
        bf16x8 kw[16];
#pragma unroll
        for (int t = 0; t < 8; ++t) { const bf16* Kp = Kp0 + (size_t)((t >> 1) * 64 + 4 * (t & 1)) * 512; kw[2 * t] = ld16(Kp); kw[2 * t + 1] = ld16(Kp + 32); }
#pragma unroll
        for (int gi = 0; gi < 4; ++gi)
#pragma unroll
            for (int dt = 0; dt < 4; ++dt) vw[gi * 4 + dt] = ld16(vb + (size_t)dt * 16 * SEQ + gi * 64);
#pragma unroll
        for (int t = 0; t < 8; ++t) { f32x4 z = {0.f, 0.f, 0.f, 0.f}; z = MMA16(kw[2 * t], q0, z); z = MMA16(kw[2 * t + 1], q1, z); st[t] = z; }
    } else {
#pragma unroll
        for (int t = 0; t < 8; ++t) { f32x4 z = {0.f, 0.f, 0.f, 0.f};
            z = MMA16(*(const LAS bf16x8*)(kl + t * 16 * 144), q0, z); z = MMA16(*(const LAS bf16x8*)(kl + t * 16 * 144 + 64), q1, z); st[t] = z; }
    }
    float mx = -1e30f;
#pragma unroll
    for (int t = 0; t < 8; ++t) {
#pragma unroll
        for (int j = 0; j < 4; ++j) { float s = st[t][j] * 0.125f;
            if (ISW) { const int kc = kstart + 8 * fq + 4 * (t & 1) + j; const bool ok = (kc >= ws_) && (kc < ws_ + 16); const int dc = min(max(kc - qc + 15, 0), 30);
                s += rp0[(t >> 1) * 31 + dc]; s = ok ? s : -1e30f; }
            st[t][j] = s; mx = fmaxf(mx, s); } }
    mx = fmaxf(mx, __shfl_xor(mx, 16)); mx = fmaxf(mx, __shfl_xor(mx, 32));
    const float mnew = fmaxf(S.mrun, mx), resc = __builtin_amdgcn_exp2f((S.mrun - mnew) * LOG2E);
    S.mrun = mnew; float ls = 0.f;
#pragma unroll
    for (int t = 0; t < 8; ++t)
#pragma unroll
        for (int j = 0; j < 4; ++j) { const float p = __builtin_amdgcn_exp2f((st[t][j] - mnew) * LOG2E); st[t][j] = p; ls += p; }
    ls += __shfl_xor(ls, 16); ls += __shfl_xor(ls, 32);
    S.l = S.l * resc + ls;
#pragma unroll
    for (int dt = 0; dt < 4; ++dt) S.o[dt] = S.o[dt] * resc;
#pragma unroll
    for (int gi = 0; gi < 4; ++gi) { u32x4 pw; pw.x = pk2(st[2 * gi][0], st[2 * gi][1]); pw.y = pk2(st[2 * gi][2], st[2 * gi][3]); pw.z = pk2(st[2 * gi + 1][0], st[2 * gi + 1][1]); pw.w = pk2(st[2 * gi + 1][2], st[2 * gi + 1][3]);
        const bf16x8 pf = __builtin_bit_cast(bf16x8, pw);
        if (ISW) {
#pragma unroll
            for (int dt = 0; dt < 4; ++dt) S.o[dt] = MMA16(vw[gi * 4 + dt], pf, S.o[dt]);
        } else {
#pragma unroll
            for (int dt = 0; dt < 4; ++dt) S.o[dt] = MMA16(*(const LAS bf16x8*)(vl + dt * 16 * 528 + gi * 64), pf, S.o[dt]);
        } }
}
__device__ __forceinline__ void na_block_lw(NaState& S, const bf16x8 q0, const bf16x8 q1, const LAS unsigned char* Kl, const LAS unsigned char* Vl, const LAS float* rph,
                                            int rowb, int grow, int r0, int kstart, int qc, int ws_, int fr, int fq) {
    f32x4 st[8];
    const LAS unsigned char* kl = Kl + (size_t)(kstart + 8 * (fr >> 2) + (fr & 3)) * 144 + fq * 16;
#pragma unroll
    for (int t = 0; t < 8; ++t) { const LAS unsigned char* kp = kl + ((t >> 1) * 64 + 4 * (t & 1)) * 144; f32x4 z = {0.f, 0.f, 0.f, 0.f};
        z = MMA16(*(const LAS bf16x8*)kp, q0, z); z = MMA16(*(const LAS bf16x8*)(kp + 64), q1, z); st[t] = z; }
    float mx = -1e30f;
#pragma unroll
    for (int t = 0; t < 8; ++t) { const int kra = rowb + (t >> 1); const bool rowok = (kra >= r0) && (kra <= r0 + 7); const int dr = min(max(kra - grow + 7, 0), 14);
        const LAS float* rpr = rph + dr * 31;
#pragma unroll
        for (int j = 0; j < 4; ++j) { const int kc = kstart + 8 * fq + 4 * (t & 1) + j; const bool ok = rowok && (kc >= ws_) && (kc < ws_ + 16); const int dc = min(max(kc - qc + 15, 0), 30);
            float s = st[t][j] * 0.125f + rpr[dc]; s = ok ? s : -1e30f; st[t][j] = s; mx = fmaxf(mx, s); } }
    mx = fmaxf(mx, __shfl_xor(mx, 16)); mx = fmaxf(mx, __shfl_xor(mx, 32));
    const float mnew = fmaxf(S.mrun, mx), resc = __builtin_amdgcn_exp2f((S.mrun - mnew) * LOG2E);
    S.mrun = mnew; float ls = 0.f;
#pragma unroll
    for (int t = 0; t < 8; ++t)
#pragma unroll
        for (int j = 0; j < 4; ++j) { const float p = __builtin_amdgcn_exp2f((st[t][j] - mnew) * LOG2E); st[t][j] = p; ls += p; }
    ls += __shfl_xor(ls, 16); ls += __shfl_xor(ls, 32);
    S.l = S.l * resc + ls;
#pragma unroll
    for (int dt = 0; dt < 4; ++dt) S.o[dt] = S.o[dt] * resc;
    const LAS unsigned char* vl = Vl + (size_t)fr * 528 + (kstart + 8 * fq) * 2;
#pragma unroll
    for (int gi = 0; gi < 4; ++gi) { u32x4 pw; pw.x = pk2(st[2 * gi][0], st[2 * gi][1]); pw.y = pk2(st[2 * gi][2], st[2 * gi][3]); pw.z = pk2(st[2 * gi + 1][0], st[2 * gi + 1][1]); pw.w = pk2(st[2 * gi + 1][2], st[2 * gi + 1][3]);
        const bf16x8 pf = __builtin_bit_cast(bf16x8, pw);
#pragma unroll
        for (int dt = 0; dt < 4; ++dt) S.o[dt] = MMA16(*(const LAS bf16x8*)(vl + dt * 16 * 528 + gi * 128), pf, S.o[dt]); }
}
template <bool WIN>
__device__ __forceinline__ void na_item(unsigned char* U, bf16* Aout, const LAS float* rp, const LAS unsigned char* Kl, const LAS unsigned char* Vl, int bl, int h, int qrow0, int grow, int cb, int lane) {
    const int fr = lane & 15, fq = lane >> 4;
    const bf16* QN = (const bf16*)(U + U_QN); const bf16* KN = (const bf16*)(U + U_KN); const bf16* VT = (const bf16*)(U + U_VT);
    const bf16* Qp = QN + (size_t)(qrow0 + fr) * 512 + h * 64 + fq * 8;
    const bf16x8 q0 = ld16(Qp), q1 = ld16(Qp + 32);
    const int r0 = min(max(grow - 4, 0), 56), kstart = min(max(16 * cb - 8, 0), 32), koff = 8 * (fr >> 2) + (fr & 3);
    const int qc = 16 * cb + fr, ws_ = min(max(qc - 8, 0), 48);
    NaState S;
#pragma unroll
    for (int dt = 0; dt < 4; ++dt) S.o[dt] = (f32x4){0.f, 0.f, 0.f, 0.f};
    S.mrun = -1e30f; S.l = 0.f;
    if (WIN) {
#pragma unroll 1
        for (int blk = 0; blk < 2; ++blk) {
            const bf16* Kp0 = KN + (size_t)(bl * SEQ + (r0 + 4 * blk) * 64 + kstart + koff) * 512 + h * 64 + fq * 8;
            const bf16* vb = VT + (size_t)((bl * 8 + h) * 64 + fr) * SEQ + (r0 + 4 * blk) * 64 + kstart + 8 * fq;
            na_block<true>(S, q0, q1, Kp0, vb, Kl, Vl, rp + (h * 15 + (r0 + 4 * blk - grow + 7)) * 31, kstart, qc, ws_, fq);
            EPI_FENCE();
        }
    }
#pragma unroll 1
    for (int blk = 0; blk < 2; ++blk) {
        na_block<false>(S, q0, q1, KN, VT, Kl + (size_t)(128 * blk + fr) * 144 + fq * 16, Vl + (size_t)fr * 528 + (128 * blk + 8 * fq) * 2, rp, 0, 0, 0, fq);
        EPI_FENCE();
    }
    const float inv = 1.f / S.l;
    bf16* op = Aout + (size_t)(qrow0 + fr) * 512 + h * 64 + 4 * fq;
#pragma unroll
    for (int dt = 0; dt < 4; ++dt) { u32x2 w; w.x = pk2(S.o[dt][0] * inv, S.o[dt][1] * inv); w.y = pk2(S.o[dt][2] * inv, S.o[dt][3] * inv); ST8(op + dt * 16, w); }
}

template <int GI>
__device__ __forceinline__ void pool_item(unsigned char* U, const bf16* PW, const float* pscale, bf16* Pout, int row0, int lane) {
    constexpr int g = GI, W = 2 << GI, hw = 1 << GI;
    const int fr = lane & 15, fq = lane >> 4;
    const bf16* UP = (const bf16*)(U + U_UP);
    const int row = row0 + fr;
    int t, n; if (row < LROWS) { t = row & (SEQ - 1); n = SEQ; } else { t = (row - LROWS) & (CTXL - 1); n = CTXL; }
    const int sbase = row - t;
    const int lo = max(t - hw, 0), hi = min(t + hw, n);
    const float inv = 1.f / (float)(hi - lo);
    f32x4 acc[8];
#pragma unroll
    for (int dt = 0; dt < 8; ++dt) acc[dt] = (f32x4){0.f, 0.f, 0.f, 0.f};
#pragma unroll
    for (int ks = 0; ks < 4; ++ks) { const int c0 = g * 128 + ks * 32 + fq * 8;
        float s0 = 0.f, s1 = 0.f, s2 = 0.f, s3 = 0.f, s4 = 0.f, s5 = 0.f, s6 = 0.f, s7 = 0.f;
        constexpr int WC = W < 8 ? W : 8;
        const u32x4 me = *(const u32x4*)(UP + (size_t)row * 512 + c0);
#pragma unroll
        for (int i0 = 0; i0 < W; i0 += WC) {
            u32x4 wv[WC];
#pragma unroll
            for (int i = 0; i < WC; ++i) { const int tt = min(max(t - hw + i0 + i, 0), n - 1); wv[i] = *(const u32x4*)(UP + (size_t)(sbase + tt) * 512 + c0); }
#pragma unroll
            for (int i = 0; i < WC; ++i) { const int tt = t - hw + i0 + i; const float ok = (tt >= 0 && tt < n) ? 1.f : 0.f; const u32x4 v = wv[i];
                s0 += ok * bflo(v.x); s1 += ok * bfhi(v.x); s2 += ok * bflo(v.y); s3 += ok * bfhi(v.y); s4 += ok * bflo(v.z); s5 += ok * bfhi(v.z); s6 += ok * bflo(v.w); s7 += ok * bfhi(v.w); }
            EPI_FENCE();
        }
        u32x4 pw; pw.x = pk2(s0 * inv - bflo(me.x), s1 * inv - bfhi(me.x)); pw.y = pk2(s2 * inv - bflo(me.y), s3 * inv - bfhi(me.y));
        pw.z = pk2(s4 * inv - bflo(me.z), s5 * inv - bfhi(me.z)); pw.w = pk2(s6 * inv - bflo(me.w), s7 * inv - bfhi(me.w));
        const bf16x8 pf = __builtin_bit_cast(bf16x8, pw);
        EPI_FENCE();
#pragma unroll
        for (int dt = 0; dt < 8; ++dt) { const bf16x8 wf = ld16(PW + (size_t)(g * 128 + dt * 16 + fr) * 128 + ks * 32 + fq * 8); acc[dt] = MMA16(wf, pf, acc[dt]); if ((dt & 3) == 3) EPI_FENCE(); }
        }
#pragma unroll
    for (int dt = 0; dt < 8; ++dt) { const int col = g * 128 + dt * 16 + 4 * fq; const f32x4 sc = *(const f32x4*)(pscale + col); const f32x4 y = acc[dt] * sc;
        u32x2 w; w.x = pk2(y[0], y[1]); w.y = pk2(y[2], y[3]); ST8(Pout + (size_t)row * 512 + col, w); }
}

__device__ __forceinline__ void contrib_item(unsigned char* U, float* ST, int bl, int h, bool isctx, int C, int dvt, int lane) {
    const int fr = lane & 15, fq = lane >> 4;
    const int n = isctx ? CTXL : SEQ;
    const bf16* VTR = (const bf16*)(U + (isctx ? U_VTRC : U_VTR));
    bf16x8 vf[4];
#pragma unroll
    for (int ks = 0; ks < 4; ++ks) vf[ks] = ld16(VTR + (size_t)((bl * 4 + h) * 128 + dvt * 16 + fr) * n + C * 128 + ks * 32 + fq * 8);
#pragma unroll
    for (int dir = 0; dir < 2; ++dir) {
        const bf16* KT = (const bf16*)(U + (dir == 0 ? (isctx ? U_KTFC : U_KTF) : (isctx ? U_KTBC : U_KTB)));
        const int step = dir == 0 ? (isctx ? C : 2 + C) : (isctx ? 1 - C : 2 + 31 - C);
        float* sp = ST + ((size_t)(((bl * 4 + h) * 2 + dir) * 34 + step)) * 8192 + (dvt * 16 + 4 * fq) * 64 + fr;
#pragma unroll
        for (int dkt = 0; dkt < 4; ++dkt) { f32x4 a = {0.f, 0.f, 0.f, 0.f};
#pragma unroll
            for (int ks = 0; ks < 4; ++ks) { const bf16x8 kf = ld16(KT + (size_t)((bl * 4 + h) * 64 + dkt * 16 + fr) * n + C * 128 + ks * 32 + fq * 8); a = MMA16(vf[ks], kf, a); }
#pragma unroll
            for (int j = 0; j < 4; ++j) sp[j * 64 + dkt * 16] = a[j];
            EPI_FENCE(); }
    }
}

constexpr int RO_K = 0, RO_V = 18432, RO_PF = 18432 + 34816, RO_PB = RO_PF + 18432, RO_END = RO_PB + 18432;
__device__ __forceinline__ void retout_item(unsigned char* U, const LAS unsigned char* L, bf16* Rout, const float* gn, float l2f, float l2b, int bl, int h, bool isctx, int C, int qt, int lane) {
    const int fr = lane & 15, fq = lane >> 4;
    const int rowbase = isctx ? (LROWS + bl * CTXL) : bl * SEQ;
    const bf16* QR = (const bf16*)(U + U_QR); const bf16* GR = (const bf16*)(U + U_GR);
    const int row = rowbase + C * 128 + qt * 16 + fr;
    const bf16* Qp = QR + (size_t)row * 256 + h * 64 + fq * 8;
    const bf16x8 q0 = ld16(Qp), q1 = ld16(Qp + 32);
    const int nq = qt * 16 + fr;
    f32x4 st[8];
    const LAS unsigned char* kl = L + RO_K + fr * 144 + fq * 16;
#pragma unroll
    for (int t = 0; t < 8; ++t) {
        f32x4 z = {0.f, 0.f, 0.f, 0.f}; z = MMA16(*(const LAS bf16x8*)(kl + t * 16 * 144), q0, z); z = MMA16(*(const LAS bf16x8*)(kl + t * 16 * 144 + 64), q1, z);
#pragma unroll
        for (int j = 0; j < 4; ++j) { const int mm = 32 * (t >> 1) + 8 * fq + 4 * (t & 1) + j; const int dl = nq - mm; const float w = __builtin_amdgcn_exp2f(dl >= 0 ? l2f * (float)dl : l2b * (float)(-dl)); z[j] *= w; }
        st[t] = z; }
    f32x4 o[8];
#pragma unroll
    for (int dt = 0; dt < 8; ++dt) o[dt] = (f32x4){0.f, 0.f, 0.f, 0.f};
    const LAS unsigned char* vl = L + RO_V + fr * 272 + fq * 16;
#pragma unroll
    for (int gi = 0; gi < 4; ++gi) { u32x4 pw; pw.x = pk2(st[2 * gi][0], st[2 * gi][1]); pw.y = pk2(st[2 * gi][2], st[2 * gi][3]); pw.z = pk2(st[2 * gi + 1][0], st[2 * gi + 1][1]); pw.w = pk2(st[2 * gi + 1][2], st[2 * gi + 1][3]);
        const bf16x8 pf = __builtin_bit_cast(bf16x8, pw);
#pragma unroll
        for (int dt = 0; dt < 8; ++dt) o[dt] = MMA16(*(const LAS bf16x8*)(vl + dt * 16 * 272 + gi * 64), pf, o[dt]);
        EPI_FENCE(); }
    const float xf = __builtin_amdgcn_exp2f(l2f * (float)(nq + 1)), xb = __builtin_amdgcn_exp2f(l2b * (float)(128 - nq));
    const LAS unsigned char* pfl = L + RO_PF + fr * 144 + fq * 16; const LAS unsigned char* pbl = L + RO_PB + fr * 144 + fq * 16;
#pragma unroll
    for (int dt = 0; dt < 8; ++dt) { f32x4 cf = {0.f, 0.f, 0.f, 0.f}, cb = {0.f, 0.f, 0.f, 0.f};
        cf = MMA16(*(const LAS bf16x8*)(pfl + dt * 16 * 144), q0, cf); cf = MMA16(*(const LAS bf16x8*)(pfl + dt * 16 * 144 + 64), q1, cf);
        cb = MMA16(*(const LAS bf16x8*)(pbl + dt * 16 * 144), q0, cb); cb = MMA16(*(const LAS bf16x8*)(pbl + dt * 16 * 144 + 64), q1, cb);
        o[dt] = o[dt] + cf * xf + cb * xb; if (dt & 1) EPI_FENCE(); }
    float s = 0.f;
#pragma unroll
    for (int dt = 0; dt < 8; ++dt) s += (o[dt][0] + o[dt][1]) + (o[dt][2] + o[dt][3]);
    s += __shfl_xor(s, 16); s += __shfl_xor(s, 32);
    const float mu = s * (1.f / 128.f); float q = 0.f;
#pragma unroll
    for (int dt = 0; dt < 8; ++dt) { const f32x4 d = o[dt] - mu; q += (d[0] * d[0] + d[1] * d[1]) + (d[2] * d[2] + d[3] * d[3]); }
    q += __shfl_xor(q, 16); q += __shfl_xor(q, 32);
    const float rstd = rsqrtf(q * (1.f / 128.f) + 1e-5f);
#pragma unroll
    for (int dt = 0; dt < 8; ++dt) { const int col = h * 128 + dt * 16 + 4 * fq; const f32x4 gg = *(const f32x4*)(gn + col); const u32x2 gw = *(const u32x2*)(GR + (size_t)row * 512 + col);
        const float g0 = bflo(gw.x), g1 = bfhi(gw.x), g2 = bflo(gw.y), g3 = bfhi(gw.y);
        const f32x4 y = (o[dt] - mu) * rstd * gg;
        u32x2 w; w.x = pk2(g0 * sigm(g0) * y[0], g1 * sigm(g1) * y[1]); w.y = pk2(g2 * sigm(g2) * y[2], g3 * sigm(g3) * y[3]);
        ST8(Rout + (size_t)row * 512 + col, w); }
}

#define RLX_AGENT __ATOMIC_RELAXED, __HIP_MEMORY_SCOPE_AGENT
#define XB_TMO      128
#define XB_XCNT(j)  (256  + 64 * (j))
#define XB_XSUB(j)  (1280 + 64 * (j))
#define XB_XGEN(j)  (2304 + 64 * (j))
#define XB_TOP      3328
#define XB_TOPGEN   3392
#define XCD_BAR_WORDS 3456
#define XB_SPIN_CAP (1u << 18)

__device__ __forceinline__ unsigned xb_ld(unsigned* p)              { return __hip_atomic_load(p, __ATOMIC_RELAXED, __HIP_MEMORY_SCOPE_AGENT); }
__device__ __forceinline__ unsigned xb_add(unsigned* p, unsigned v) { return __hip_atomic_fetch_add(p, v, __ATOMIC_RELAXED, __HIP_MEMORY_SCOPE_AGENT); }
__device__ __forceinline__ unsigned xb_xcc_id() { return (unsigned)__builtin_amdgcn_s_getreg((3 << 11) | 20) & 0xFu; }
#define XB_SPIN(cond, bar) do { unsigned _sp = 0; while (cond) { __builtin_amdgcn_s_sleep(1); \
    if ((++_sp & 255u) == 0u) { if (xb_ld(&(bar)[XB_TMO])) break; if (_sp > XB_SPIN_CAP) { atomicAdd(&(bar)[XB_TMO], 1u); break; } } } } while (0)

struct XcdBarrier {
    unsigned* bar; unsigned x;
    volatile LAS unsigned* st;
};

__device__ __forceinline__ XcdBarrier xcd_barrier_post(unsigned* bar, volatile LAS unsigned* st) {
    XcdBarrier b; b.bar = bar; b.x = xb_xcc_id(); b.st = st;
    if (threadIdx.x == 0) (void)xb_add(&bar[XB_XCNT(b.x)], 1u);
    return b;
}
__device__ __forceinline__ void xcd_barrier_complete(unsigned* bar, unsigned x, unsigned& nloc, unsigned& nx) {
    const unsigned G = gridDim.x * gridDim.y * gridDim.z;
    unsigned sum, cnt, mine, sp = 0u;
    for (;;) {
        sum = 0u; cnt = 0u; mine = 0u;
#pragma unroll
        for (unsigned j = 0; j < 16; ++j) { const unsigned c = xb_ld(&bar[XB_XCNT(j)]); sum += c; cnt += (c > 0u) ? 1u : 0u; mine = (j == x) ? c : mine; }
        if (sum == G) break;
        __builtin_amdgcn_s_sleep(1);
        if ((++sp & 255u) == 0u) { if (xb_ld(&bar[XB_TMO])) break; if (sp > XB_SPIN_CAP) { atomicAdd(&bar[XB_TMO], 1u); break; } }
    }
    nloc = mine > 0u ? mine : 1u; nx = cnt > 0u ? cnt : 1u;
}

__device__ __forceinline__ void xcd_barrier(const XcdBarrier& b) {
    asm volatile("s_waitcnt vmcnt(0)" ::: "memory");
    __syncthreads();
    if (threadIdx.x == 0) {
        unsigned* bar = b.bar;
        __builtin_amdgcn_s_waitcnt(0);
        unsigned nloc = b.st[0], nx = b.st[1];
        if (nloc == 0u) { xcd_barrier_complete(bar, b.x, nloc, nx); b.st[0] = nloc; b.st[1] = nx; }
        const unsigned old = xb_add(&bar[XB_XSUB(b.x)], 1u);
        const unsigned gen = old / nloc;
        if (old + 1u == (gen + 1u) * nloc) {
            __builtin_amdgcn_fence(__ATOMIC_RELEASE, "agent");
            asm volatile("s_waitcnt vmcnt(0)" ::: "memory");
            const unsigned og = xb_add(&bar[XB_TOP], 1u);
            const unsigned tg = og / nx;
            if (og + 1u == (tg + 1u) * nx) xb_add(&bar[XB_TOPGEN], 1u);
            else XB_SPIN(xb_ld(&bar[XB_TOPGEN]) == tg, bar);
            __builtin_amdgcn_fence(__ATOMIC_ACQUIRE, "agent");
            xb_add(&bar[XB_XGEN(b.x)], 1u);
            asm volatile("s_waitcnt vmcnt(0)" ::: "memory");
        } else {
            XB_SPIN(xb_ld(&bar[XB_XGEN(b.x)]) == gen, bar);
            __builtin_amdgcn_fence(__ATOMIC_ACQUIRE, "agent");
            asm volatile("s_waitcnt vmcnt(0)" ::: "memory");
        }
    }
    __syncthreads();
}

__global__ void __launch_bounds__(NWAVES * 64, 2) fwd_megakernel(Args args) {
    extern __shared__ __attribute__((aligned(16))) unsigned char lds_raw[];
    LAS unsigned char* lds = (LAS unsigned char*)lds_raw;
    cg::grid_group grid = cg::this_grid();
    const int tid0 = threadIdx.x, wave = __builtin_amdgcn_readfirstlane(tid0 >> 6);
    const int G = gridDim.x, gw = blockIdx.x * NWAVES + wave, NGW = G * NWAVES;
    unsigned char* ws = args.ws;
    const float* x = args.in[0]; const float* cvec = args.in[1]; const float* ctx = args.in[2]; const float* cctx = args.in[3];
    float* out = args.out; float* HC = (float*)(ws + WS_HC);
    float* MOD = (float*)(ws + WS_MOD); float* RT = (float*)(ws + WS_RT);
    unsigned char* U = ws + WS_U;
    const int lo = args.ph_lo, hi = args.ph_hi;
    int pid = 0;
    if (tid0 < 64) ((LAS unsigned*)(lds + 131072))[tid0] = 0u;
    if (blockIdx.x == 0 && lo == 0) { unsigned* bw = (unsigned*)(ws + WS_BAR); for (int i = tid0; i < XCD_BAR_WORDS; i += NWAVES * 64) __hip_atomic_store(bw + i, 0u, __ATOMIC_RELAXED, __HIP_MEMORY_SCOPE_AGENT); }
    __syncthreads();
    XcdBarrier xbar; xbar.bar = (unsigned*)(ws + WS_BAR); xbar.x = 0; xbar.st = nullptr;
#define PH_BEGIN if (pid >= lo && pid < hi) { int tid = tid0; asm volatile("" : "+v"(tid)); const int lane = tid & 63; (void)lane;
#define PH_END } if (pid >= lo && pid + 1 < hi) { if (pid == 0) { grid.sync(); xbar = xcd_barrier_post((unsigned*)(ws + WS_BAR), (volatile LAS unsigned*)(lds + 131072)); } else { for (int s_ = 0; s_ < NSYNC; ++s_) xcd_barrier(xbar); } } ++pid;

    PH_BEGIN
#ifndef OFF0
#pragma unroll 1
            for (int rep_ = 0; rep_ < REP0; ++rep_) {
    {
        LAS float* sv = (LAS float*)lds;
        LAS float* red = (LAS float*)(lds + 40960);
        for (int i = tid; i < 9 * D; i += NWAVES * 64) { const float v = (i < 8 * D) ? cvec[i] : cctx[i - 8 * D]; sv[i] = v / (1.f + expf(-v)); }
        __syncthreads();
        for (int item = blockIdx.x; item < 2 * 96; item += G) {
            const int l = item / 96, col = (item % 96) * 64 + lane;
            const float* wa = args.in[6] + (size_t)l * D * NMODC + col;
            float a[9];
#pragma unroll
            for (int b = 0; b < 9; ++b) a[b] = 0.f;
#pragma unroll 16
            for (int kk = 0; kk < 128; ++kk) { const int k = wave * 128 + kk; const float wv = wa[(size_t)k * NMODC];
#pragma unroll
                for (int b = 0; b < 9; ++b) a[b] += sv[b * D + k] * wv; }
#pragma unroll
            for (int b = 0; b < 9; ++b) red[(wave * 9 + b) * 64 + lane] = a[b];
            __syncthreads();
            for (int o = tid; o < 9 * 64; o += NWAVES * 64) { const int b = o >> 6, ln = o & 63; float s = 0.f;
#pragma unroll
                for (int w = 0; w < 8; ++w) s += red[(w * 9 + b) * 64 + ln];
                const int cc = (item % 96) * 64 + ln; MOD[((size_t)l * 9 + b) * NMODC + cc] = s + args.in[7][(size_t)l * NMODC + cc]; }
            __syncthreads();
        }
        if (blockIdx.x == G - 1) { for (int i = tid; i < 64 * 16; i += NWAVES * 64) { const int pos = i >> 4, f = i & 15; const float inv = powf(10000.f, -(float)f / 16.f); const float ang = (float)pos * inv;
            RT[2 * i] = cosf(ang); RT[2 * i + 1] = sinf(ang); } }
        __syncthreads();
        LAS float* scr = (LAS float*)(lds + wave * 16384);
        constexpr int I_IN = 16 * (INW / 32), I_BR = 8 * 32, I_O = 16 * 32, I_G = 16 * (FF / 32), I_D = (FF / 64) * 32, I_P = 2 * 4;
        constexpr int I_LAYER = I_IN + 3 * I_BR + I_O + 2 * I_G + I_D + 4 * I_P;
        for (int it = gw; it < 2 * I_LAYER; it += NGW) {
            const int l = it / I_LAYER; int r = it - l * I_LAYER; unsigned char* wl = ws + WS_W + (size_t)l * WL_STRIDE;
            if (r < I_IN) { transpose_item(args.in[8] + (size_t)l * D * INW, D, INW, (bf16*)(wl + W_IN), 0, scr, r, lane); continue; } r -= I_IN;
            if (r < I_BR) { transpose_item(args.in[15] + (size_t)l * 512 * D, 512, D, (bf16*)(wl + W_BA), 0, scr, r, lane); continue; } r -= I_BR;
            if (r < I_BR) { transpose_item(args.in[16] + (size_t)l * 512 * D, 512, D, (bf16*)(wl + W_BB), 0, scr, r, lane); continue; } r -= I_BR;
            if (r < I_BR) { transpose_item(args.in[17] + (size_t)l * 512 * D, 512, D, (bf16*)(wl + W_BC), 0, scr, r, lane); continue; } r -= I_BR;
            if (r < I_O) { transpose_item(args.in[18] + (size_t)l * D * D, D, D, (bf16*)(wl + W_O), 0, scr, r, lane); continue; } r -= I_O;
            if (r < I_G) { transpose_item(args.in[19] + (size_t)l * D * FF, D, FF, (bf16*)(wl + W_GU), 1, scr, r, lane); continue; } r -= I_G;
            if (r < I_G) { transpose_item(args.in[20] + (size_t)l * D * FF, D, FF, (bf16*)(wl + W_GU), 2, scr, r, lane); continue; } r -= I_G;
            if (r < I_D) { transpose_item(args.in[21] + (size_t)l * FF * D, FF, D, (bf16*)(wl + W_D), 0, scr, r, lane); continue; } r -= I_D;
            { const int g = r / I_P; transpose_item(args.in[13] + ((size_t)l * 4 + g) * 128 * 128, 128, 128, (bf16*)(wl + W_P) + (size_t)g * 128 * 128, 0, scr, r % I_P, lane); }
        }
        __syncthreads();
    }
            }
#endif
    PH_END

#pragma unroll 1
    for (int l = 0; l < 2; ++l) {
        const bool with_ctx = (l == 0);
        unsigned char* wl = ws + WS_W + (size_t)l * WL_STRIDE;
        const float* modl = MOD + (size_t)l * 9 * NMODC;
        const float* hl = (l == 0) ? x : out; const float* hcs = (l == 0) ? ctx : HC;
        PH_BEGIN
#ifndef OFF1
#pragma unroll 1
            for (int rep_ = 0; rep_ < REP1; ++rep_) {
            for (int rr = gw; rr < 2 * HROWS; rr += NGW) {
                const int g = rr >= HROWS ? 1 : 0, r = rr - g * HROWS;
                const float* src; int bidx;
                if (r < LROWS) { const int gr = g * LROWS + r; src = hl + (size_t)gr * D; bidx = gr >> 12; } else { const int gc = g * CROWS + (r - LROWS); src = hcs + (size_t)gc * D; bidx = 8; }
                norm_row(src, (bf16*)(ws + WS_XN) + (size_t)rr * D, args.in[4] + l * D, modl + bidx * NMODC, modl + bidx * NMODC + D, lane);
            }
            }
#endif
        PH_END
#pragma unroll 1
        for (int s = 0; s < 3; ++s) {
            PH_BEGIN
            if (s == 2) {
                const int g = 1;
                const int Mr = with_ctx ? HROWS : LROWS;
                pg8::Gemm gm{(const bf16*)(ws + WS_XN + g * XN_HALF), (const bf16*)(wl + W_O), 0, 0, Mr, D, D};
                pg8::StaticOrder S; S.init(Mr, D, G, (int)blockIdx.x);
                EpiResid E{hl, hcs, out, HC, modl + 2 * D, LROWS / 256, g * LROWS, g * CROWS};
                pg8::gemm_phase<EpiResid, pg8::StaticOrder, ALIGN_SMALL, true>(lds, gm, S, E);
            }
            if (s == 2) {
                for (int q = NGW - 1 - gw; q < (with_ctx ? HROWS : LROWS); q += NGW) {
                    const int r = q < LROWS ? q : TLAT + (q - LROWS);
                    const float* src; int bidx;
                    if (r < TLAT) { src = out + (size_t)r * D; bidx = r >> 12; } else { src = HC + (size_t)(r - TLAT) * D; bidx = 8; }
                    norm_row(src, (bf16*)(ws + WS_FX) + (size_t)r * D, args.in[5] + l * D, modl + bidx * NMODC + 3 * D, modl + bidx * NMODC + 4 * D, lane);
                }
            }
            if (s < 2) {
                const int g = s;
                EpiInproj E{U};
                if (g == 1 && with_ctx) {
                    pg8::Gemm gm{(const bf16*)(ws + WS_XN + g * XN_HALF), (const bf16*)(wl + W_IN), 0, (long)3584 * D, HROWS, INW, D};
                    pg8::InprojOrder S; S.SA.init(HROWS, 3584, 1, 0); S.SB.init(HROWS, 3072, 1, 0); S.lo = IP_TAIL; S.nA = (HROWS / 256) * 14 - IP_TAIL; S.nB = (HROWS / 256) * 12; S.G = G; S.c = (int)blockIdx.x;
                    pg8::gemm_phase<EpiInproj, pg8::InprojOrder, true, true>(lds, gm, S, E);
                } else {
                    pg8::Gemm gm{(const bf16*)(ws + WS_XN + g * XN_HALF), (const bf16*)(wl + W_IN), 0, 0, HROWS, INW, D};
                    pg8::StaticOrder S; S.init(HROWS, INW, G, (int)blockIdx.x);
                    pg8::gemm_phase<EpiInproj, pg8::StaticOrder, true, true>(lds, gm, S, E);
                }
            }
            PH_END
            if (s < 2) {
            const int g = s;
            PH_BEGIN
#ifndef OFF3
#pragma unroll 1
            for (int rep_ = 0; rep_ < REP3; ++rep_) {
            {
                constexpr int NA_K_OFF = 0, NA_V_OFF = 36864, NA_RP_OFF = 36864 + 33792;
                LAS float* rp = (LAS float*)(lds + NA_RP_OFF);
                for (int i = tid; i < 8 * 15 * 31; i += NWAVES * 64) rp[i] = args.in[9][(size_t)l * 8 * 15 * 31 + i];
                bf16* Aout = (bf16*)(ws + WS_ARP); bf16* Pout = (bf16*)(ws + WS_ARP + 34 * MiB);
                const int vcu = (G % 8 == 0) ? ((int)blockIdx.x % 8) * (G / 8) + (int)blockIdx.x / 8 : (int)blockIdx.x;
                const int nb_na = HB * 8 * 8, nb_nac = 0;
#ifndef M1_NO_NA
#pragma unroll 1
                for (int bi = vcu; bi < nb_na; bi += G) {
                    const int rg = bi & 7, h = (bi >> 3) & 7, bl = bi >> 6, R = rg * 8;
                    const int fr = lane & 15, fq = lane >> 4, cb = wave & 3, rw = R + (wave >> 2) * 4;
                    const int kstart = min(max(16 * cb - 8, 0), 32), qc = 16 * cb + fr, ws_ = min(max(qc - 8, 0), 48);
                    NaState S4[4];
                    const bf16* Qp0 = (const bf16*)(U + U_QN) + (size_t)(bl * SEQ + rw * 64 + cb * 16 + fr) * 512 + h * 64 + fq * 8;
                    __syncthreads();
                    {
                        const bf16* KN = (const bf16*)(U + U_KN) + (size_t)(LROWS + bl * CTXL) * 512 + h * 64; const bf16* VTC = (const bf16*)(U + U_VTC) + (size_t)((bl * 8 + h) * 64) * CTXL;
#pragma unroll
                        for (int i = 0; i < 4; ++i) { const int ch = tid + i * 512; const int key = ch >> 3, c = ch & 7;
                            const int rho = (key & ~31) + 16 * ((key >> 2) & 1) + 4 * ((key >> 3) & 3) + (key & 3);
                            *(LAS u32x4*)(lds + NA_K_OFF + rho * 144 + c * 16) = *(const u32x4*)(KN + (size_t)key * 512 + c * 8); }
#pragma unroll
                        for (int i = 0; i < 4; ++i) { const int ch = tid + i * 512; const int d = ch >> 5, c = ch & 31;
                            *(LAS u32x4*)(lds + NA_V_OFF + d * 528 + c * 16) = *(const u32x4*)(VTC + (size_t)d * CTXL + c * 8); }
                    }
                    __syncthreads();
                    if (with_ctx && wave < 2)
                        na_item<false>(U, Aout, rp, lds + NA_K_OFF, lds + NA_V_OFF, bl, h, LROWS + bl * CTXL + (rg * 2 + wave) * 16, 0, 0, lane);
                    EPI_FENCE();
#pragma unroll
                    for (int i = 0; i < 4; ++i) {
#pragma unroll
                        for (int dt = 0; dt < 4; ++dt) S4[i].o[dt] = (f32x4){0.f, 0.f, 0.f, 0.f};
                        S4[i].mrun = -1e30f; S4[i].l = 0.f; }
#pragma unroll
                    for (int i = 0; i < 4; ++i) {
#pragma unroll 1
                        for (int blk = 0; blk < 2; ++blk) { na_block<false>(S4[i], ld16(Qp0 + (size_t)i * 64 * 512), ld16(Qp0 + (size_t)i * 64 * 512 + 32), nullptr, nullptr, lds + NA_K_OFF + (size_t)(128 * blk + fr) * 144 + fq * 16, lds + NA_V_OFF + (size_t)fr * 528 + (128 * blk + 8 * fq) * 2, rp, 0, 0, 0, fq); EPI_FENCE(); } }
#pragma unroll 1
                    for (int kb = 0; kb < 4; ++kb) {
                        const int rowb = R - 4 + 4 * kb;
                        if (rowb + 3 < 0 || rowb > 63) continue;
                        __syncthreads();
                        {
                            const bf16* KNb = (const bf16*)(U + U_KN) + (size_t)(bl * SEQ) * 512 + h * 64; const bf16* VTb = (const bf16*)(U + U_VT) + (size_t)((bl * 8 + h) * 64) * SEQ;
#pragma unroll
                            for (int i = 0; i < 4; ++i) { const int ch = tid + i * 512; const int key = ch >> 3, c = ch & 7; const int row = min(max(rowb + (key >> 6), 0), 63);
                                *(LAS u32x4*)(lds + NA_K_OFF + key * 144 + c * 16) = *(const u32x4*)(KNb + (size_t)(row * 64 + (key & 63)) * 512 + c * 8); }
#pragma unroll
                            for (int i = 0; i < 4; ++i) { const int ch = tid + i * 512; const int d = ch >> 5, krl = (ch >> 3) & 3, c = ch & 7; const int row = min(max(rowb + krl, 0), 63);
                                *(LAS u32x4*)(lds + NA_V_OFF + d * 528 + (krl * 64 + c * 8) * 2) = *(const u32x4*)(VTb + (size_t)d * SEQ + row * 64 + c * 8); }
                        }
                        __syncthreads();
#pragma unroll
                        for (int i = 0; i < 4; ++i) { const int grow = rw + i, r0 = min(max(grow - 4, 0), 56);
                            if (rowb + 3 >= r0 && rowb <= r0 + 7) {
                                na_block_lw(S4[i], ld16(Qp0 + (size_t)i * 64 * 512), ld16(Qp0 + (size_t)i * 64 * 512 + 32), lds + NA_K_OFF, lds + NA_V_OFF, rp + h * 15 * 31, rowb, grow, r0, kstart, qc, ws_, fr, fq); EPI_FENCE(); } }
                    }
#pragma unroll
                    for (int i = 0; i < 4; ++i) { const float inv = 1.f / S4[i].l; bf16* op = Aout + (size_t)(bl * SEQ + (rw + i) * 64 + cb * 16 + fr) * 512 + h * 64 + 4 * fq;
#pragma unroll
                        for (int dt = 0; dt < 4; ++dt) { u32x2 w; w.x = pk2(S4[i].o[dt][0] * inv, S4[i].o[dt][1] * inv); w.y = pk2(S4[i].o[dt][2] * inv, S4[i].o[dt][3] * inv); ST8(op + dt * 16, w); } }
                }
#endif
                const int n_pt = (with_ctx ? HROWS : LROWS) / 16, n_con = HB * 4 * 34 * 8;
#pragma unroll 1
                for (int rpc_ = 0; rpc_ < REP_PC; ++rpc_) {
#ifndef M1_NO_POOL
                    const bf16* PWp = (const bf16*)(wl + W_P); const float* psc = args.in[14] + l * 512;
#pragma unroll 1
                    for (int rpool_ = 0; rpool_ < REP_POOL; ++rpool_) {
#pragma unroll 1
                    for (int it = gw; it < n_pt; it += NGW) pool_item<3>(U, PWp, psc, Pout, it * 16, lane);
                    EPI_FENCE();
#pragma unroll 1
                    for (int it = (gw + NGW / 2) % NGW; it < n_pt; it += NGW) pool_item<2>(U, PWp, psc, Pout, it * 16, lane);
                    EPI_FENCE();
#pragma unroll 1
                    for (int it = (gw + NGW / 4) % NGW; it < n_pt; it += NGW) pool_item<1>(U, PWp, psc, Pout, it * 16, lane);
                    EPI_FENCE();
#pragma unroll 1
                    for (int it = (gw + 3 * NGW / 4) % NGW; it < n_pt; it += NGW) pool_item<0>(U, PWp, psc, Pout, it * 16, lane);
                    EPI_FENCE();
                    }
#endif
#ifndef M1_NO_CON
#pragma unroll 1
                    for (int bi = blockIdx.x; bi < HB * 4 * 34; bi += G) {
                        const int ch = bi % 34, bh = bi / 34, h = bh & 3, bl = bh >> 2; const bool ic = ch < 2; const int C = ic ? ch : ch - 2;
                        { const int row0 = (ic ? LROWS + bl * CTXL : bl * SEQ) + C * 128 + ((wave >> 1) & 1) * 64;
                            rope_item(U, RT, lg2_of_logit(args.in[10][l * 4 + h]), lg2_of_logit(args.in[11][l * 4 + h]), row0, h, wave & 1, wave >> 2, lane); }
                        asm volatile("s_waitcnt vmcnt(0)" ::: "memory");
                        __syncthreads();
                        contrib_item(U, (float*)(ws + WS_ST), bl, h, ic, C, wave, lane);
                    }
#endif
                }
                __syncthreads();
            }
            }
#endif
            PH_END
            PH_BEGIN
#ifndef OFF4
#pragma unroll 1
            for (int rep_ = 0; rep_ < REP4; ++rep_) {
            {
                const float* STp = (const float*)(ws + WS_ST); bf16* PV = (bf16*)(ws + WS_PREV);
                for (int idx = blockIdx.x * (NWAVES * 64) + tid; idx < 16 * 2 * 8192; idx += G * NWAVES * 64) {
                    const int e = idx & 8191, sd = idx >> 13, dir = sd & 1, h = (sd >> 1) & 3;
                    const float l2 = lg2_of_logit(dir == 0 ? args.in[10][l * 4 + h] : args.in[11][l * 4 + h]);
                    const float gC = exp2f(l2 * 128.f);
                    float s = 0.f; const size_t base = (size_t)sd * 34 * 8192 + e;
float cv[34];
#pragma unroll
                    for (int stp = 0; stp < 34; ++stp) cv[stp] = STp[base + (size_t)stp * 8192];
#pragma unroll
                    for (int stp = 0; stp < 34; ++stp) { PV[base + (size_t)stp * 8192] = bf1(s); s = s * gC + cv[stp]; }
                }
            }
            }
#endif
            PH_END
            PH_BEGIN
#ifndef OFF5
#pragma unroll 1
            for (int rep_ = 0; rep_ < REP5; ++rep_) {
            {
                bf16* Rout = (bf16*)(ws + WS_ARP + 17 * MiB);
                const int nch = with_ctx ? 34 : 32;
                const bf16* PREV = (const bf16*)(ws + WS_PREV);
                for (int bi = blockIdx.x; bi < 16 * nch; bi += G) {
                    int ch = bi % nch; const int bh = bi / nch; const int h = bh & 3, bl = bh >> 2;
                    bool ic = false; if (with_ctx) { ic = ch < 2; ch = ic ? ch : ch - 2; }
                    const int n = ic ? CTXL : SEQ; const int rowbase = ic ? (LROWS + bl * CTXL) : bl * SEQ;
                    const int stepf = ic ? ch : 2 + ch, stepb = ic ? 1 - ch : 2 + 31 - ch;
                    const bf16* KR = (const bf16*)(U + U_KR) + (size_t)(rowbase + ch * 128) * 256 + h * 64;
                    const bf16* VTR = (const bf16*)(U + (ic ? U_VTRC : U_VTR)) + (size_t)((bl * 4 + h) * 128) * n + ch * 128;
                    const bf16* Pf = PREV + ((size_t)(((bl * 4 + h) * 2 + 0) * 34 + stepf)) * 8192; const bf16* Pb = PREV + ((size_t)(((bl * 4 + h) * 2 + 1) * 34 + stepb)) * 8192;
                    __syncthreads();
#pragma unroll
                    for (int i = 0; i < 2; ++i) { const int cx = tid + i * 512; const int key = cx >> 3, c = cx & 7;
                        const int rho = (key & ~31) + 16 * ((key >> 2) & 1) + 4 * ((key >> 3) & 3) + (key & 3);
                        *(LAS u32x4*)(lds + RO_K + rho * 144 + c * 16) = *(const u32x4*)(KR + (size_t)key * 256 + c * 8);
                        *(LAS u32x4*)(lds + RO_PF + key * 144 + c * 16) = *(const u32x4*)(Pf + key * 64 + c * 8);
                        *(LAS u32x4*)(lds + RO_PB + key * 144 + c * 16) = *(const u32x4*)(Pb + key * 64 + c * 8); }
#pragma unroll
                    for (int i = 0; i < 4; ++i) { const int cx = tid + i * 512; const int dv = cx >> 4, c = cx & 15;
                        *(LAS u32x4*)(lds + RO_V + dv * 272 + c * 16) = *(const u32x4*)(VTR + (size_t)dv * n + c * 8); }
                    __syncthreads();
                    const float l2f = lg2_of_logit(args.in[10][l * 4 + h]), l2b = lg2_of_logit(args.in[11][l * 4 + h]);
                    retout_item(U, lds, Rout, args.in[12] + l * 512, l2f, l2b, bl, h, ic, ch, wave, lane);
                }
                __syncthreads();
            }
            }
#endif
            PH_END
            PH_BEGIN
#ifndef OFF6
#pragma unroll 1
            for (int rep_ = 0; rep_ < REP6; ++rep_) {
            {
                const int Mr = with_ctx ? HROWS : LROWS;
                pg8::Gemm gm{(const bf16*)(ws + WS_ARP), (const bf16*)(wl + W_BA), (long)(17 * MiB / 2), (long)(1 * MiB / 2), Mr, D, 512};
                pg8::ChainOrder S; S.S.init(Mr, D, G, (int)blockIdx.x);
                EpiMerge E{(const bf16*)(U + U_G), (bf16*)(ws + WS_XN + g * XN_HALF)};
                pg8::gemm_phase<EpiMerge, pg8::ChainOrder, ALIGN_SMALL, true>(lds, gm, S, E);
                if (g == 0 && with_ctx && (int)blockIdx.x >= 16) {
                    pg8::Gemm gi_{(const bf16*)(ws + WS_XN + XN_HALF), (const bf16*)(wl + W_IN), 0, (long)3584 * D, HROWS, INW, D};
                    pg8::InprojOrder SI; SI.SA.init(HROWS, 3584, 1, 0); SI.SB.init(HROWS, 3072, 1, 0); SI.lo = 0; SI.nA = IP_TAIL; SI.nB = 0; SI.G = G - 16; SI.c = (int)blockIdx.x - 16;
                    EpiInproj EI{U};
                    pg8::gemm_phase<EpiInproj, pg8::InprojOrder, true, true>(lds, gi_, SI, EI);
                }
                if (g == 1) {
                    const int skip = with_ctx ? 16 : 0;
                    if ((int)blockIdx.x >= skip) {
                        pg8::Gemm gw_{(const bf16*)(ws + WS_XN), (const bf16*)(wl + W_O), 0, 0, Mr, D, D};
                        pg8::StaticOrder SW; SW.init(Mr, D, G - skip, (int)blockIdx.x - skip);
                        EpiResid EW{hl, hcs, out, HC, modl + 2 * D, LROWS / 256, 0, 0};
                        pg8::gemm_phase<EpiResid, pg8::StaticOrder, ALIGN_SMALL, true>(lds, gw_, SW, EW);
                    }
                }
            }
            }
#endif
            PH_END
            }
        }
        const int Mf = with_ctx ? TROWS : TLAT;
        PH_BEGIN
#ifndef OFF8
#pragma unroll 1
            for (int rep_ = 0; rep_ < REP8; ++rep_) {
        for (int q = gw; q < (with_ctx ? HROWS : LROWS); q += NGW) {
            const int r = q < LROWS ? LROWS + q : TLAT + CROWS + (q - LROWS);
            const float* src; int bidx;
            if (r < TLAT) { src = out + (size_t)r * D; bidx = r >> 12; } else { src = HC + (size_t)(r - TLAT) * D; bidx = 8; }
            norm_row(src, (bf16*)(ws + WS_FX) + (size_t)r * D, args.in[5] + l * D, modl + bidx * NMODC + 3 * D, modl + bidx * NMODC + 4 * D, lane);
        }
            }
#endif
        PH_END
        PH_BEGIN
#ifndef OFF9
#pragma unroll 1
            for (int rep_ = 0; rep_ < REP9; ++rep_) {
        {
            pg8::Gemm gm{(const bf16*)(ws + WS_FX), (const bf16*)(wl + W_GU), 0, 0, Mf, 2 * FF, D};
            pg8::StaticOrder S; S.init(Mf, 2 * FF, G, (int)blockIdx.x);
            EpiFfn1 E{(bf16*)(ws + WS_HD)};
            pg8::gemm_phase<EpiFfn1, pg8::StaticOrder, true, true>(lds, gm, S, E);
        }
            }
#endif
        PH_END
        PH_BEGIN
#ifndef OFF10
#pragma unroll 1
            for (int rep_ = 0; rep_ < REP10; ++rep_) {
        {
            pg8::Gemm gm{(const bf16*)(ws + WS_HD), (const bf16*)(wl + W_D), 0, 0, Mf, D, FF};
            pg8::StaticOrder S; S.init(Mf, D, G, (int)blockIdx.x);
            EpiResid E{out, HC, out, HC, modl + 5 * D, TLAT / 256, 0, 0};
            pg8::gemm_phase<EpiResid, pg8::StaticOrder, ALIGN_SMALL, true>(lds, gm, S, E);
        }
            }
#endif
        PH_END
    }
    PH_BEGIN
#ifndef OFF11
#pragma unroll 1
            for (int rep_ = 0; rep_ < REP11; ++rep_) {
    for (int r = gw; r < TLAT; r += NGW) {
        float* p = out + (size_t)r * D; f32x4 v[4]; float ss = 0.f;
#pragma unroll
        for (int j = 0; j < 4; ++j) { v[j] = *(const f32x4*)(p + 4 * lane + 256 * j); ss += (v[j][0] * v[j][0] + v[j][1] * v[j][1]) + (v[j][2] * v[j][2] + v[j][3] * v[j][3]); }
        const float rstd = rsqrtf(wave_sum(ss) * (1.f / D) + 1e-6f);
#pragma unroll
        for (int j = 0; j < 4; ++j) { const int c = 4 * lane + 256 * j; *(f32x4*)(p + c) = v[j] * rstd * *(const f32x4*)(args.in[22] + c); }
    }
            }
#endif
    PH_END
#undef PH_BEGIN
#undef PH_END
}
constexpr int N_PHASES = 1 + 2 * (1 + 3 + 2 * 4 + 3) + 1;

extern "C" void kernel_launch(void* const* d_in, const int* in_sizes, int n_in, void* d_out, int out_size, void* d_ws, size_t ws_size, hipStream_t stream) {
    static int grid = 0;
    if (grid == 0) {
        if (n_in != 23 || in_sizes[0] != TLAT * D || out_size != TLAT * D || ws_size < WS_END) { fprintf(stderr, "kernel_launch: unexpected shapes / workspace (n_in %d, ws %zu)\n", n_in, ws_size); grid = -1; return; }
        int dev = 0, cus = 0, per_cu = 0;
        if (hipGetDevice(&dev) != hipSuccess || hipDeviceGetAttribute(&cus, hipDeviceAttributeMultiprocessorCount, dev) != hipSuccess) { grid = -1; return; }
        if (hipFuncSetAttribute((const void*)fwd_megakernel, hipFuncAttributeMaxDynamicSharedMemorySize, LDS_BYTES) != hipSuccess) { fprintf(stderr, "kernel_launch: hipFuncSetAttribute failed\n"); grid = -1; return; }
        if (hipOccupancyMaxActiveBlocksPerMultiprocessor(&per_cu, (const void*)fwd_megakernel, NWAVES * 64, LDS_BYTES) != hipSuccess || per_cu < 1) { fprintf(stderr, "kernel_launch: occupancy query says %d\n", per_cu); per_cu = 1; }
        (void)hipGetLastError();
        grid = cus * 1;
    }
    if (grid < 0) return;
    Args a{};
    for (int i = 0; i < 23; ++i) a.in[i] = (const float*)d_in[i];
    a.out = (float*)d_out; a.ws = (unsigned char*)d_ws;
#if MK_PER_PHASE
    for (int p = 0; p < N_PHASES; ++p) { a.ph_lo = p; a.ph_hi = p + 1; void* kargs[] = {&a};
        hipError_t e = hipLaunchCooperativeKernel((const void*)fwd_megakernel, dim3(grid), dim3(NWAVES * 64), kargs, LDS_BYTES, stream);
        if (e != hipSuccess) { fprintf(stderr, "launch %d failed: %s\n", p, hipGetErrorString(e)); break; } }
#else
    a.ph_lo = 0; a.ph_hi = N_PHASES;
    void* kargs[] = {&a};
    hipError_t e = hipLaunchCooperativeKernel((const void*)fwd_megakernel, dim3(grid), dim3(NWAVES * 64), kargs, LDS_BYTES, stream);
    if (e != hipSuccess) fprintf(stderr, "cooperative launch failed: %s (grid %d)\n", hipGetErrorString(e), grid);
#endif
}
```

```cpp
#include <hip/hip_runtime.h>
#include <hip/hip_cooperative_groups.h>
#include <cstdio>
#include <cstdint>
namespace cg = cooperative_groups;

#ifndef REP0
#define REP0 1
#endif
#ifndef REP1
#define REP1 1
#endif
#ifndef REP2
#define REP2 1
#endif
#ifndef REP3
#define REP3 1
#endif
#ifndef REP4
#define REP4 1
#endif
#ifndef REP5
#define REP5 1
#endif
#ifndef REP6
#define REP6 1
#endif
#ifndef REP7
#define REP7 1
#endif
#ifndef REP8
#define REP8 1
#endif
#ifndef REP9
#define REP9 1
#endif
#ifndef REP10
#define REP10 1
#endif
#ifndef REP11
#define REP11 1
#endif
#ifndef REP12
#define REP12 1
#endif
#ifndef REP_POOL
#define REP_POOL 1
#endif
#ifndef REP_CON
#define REP_CON 1
#endif
#ifndef REP_NA
#define REP_NA 1
#endif
#ifndef REP_PC
#define REP_PC 1
#endif
#ifndef NSYNC
#define NSYNC 1
#endif
#ifndef MK_PER_PHASE
#define MK_PER_PHASE 0
#endif

#ifndef PG8_WGM
#define PG8_WGM 8
#endif
namespace pg8 {
#define PG8_LAS __attribute__((address_space(3)))
typedef unsigned short bf16_t;
typedef short bf16x8 __attribute__((ext_vector_type(8)));
typedef float f32x4 __attribute__((ext_vector_type(4)));
typedef unsigned u32x4 __attribute__((ext_vector_type(4)));
constexpr int BM = 256, BK = 64, HALF = 128, HTB = HALF * BK * 2  , STAGE_BYTES = 8 * HTB, NXCD = 8, WGM = PG8_WGM;

__host__ __device__ __forceinline__ int lds_byte(int r, int c) { const int st = (r >> 4) * 2 + (c >> 5), rr = r & 15, cc = c & 31, ob = rr * 64 + cc * 2; return st * 1024 + (ob ^ (((ob >> 9) & 1) << 5)); }
__host__ __device__ __forceinline__ void stage_rc(int b, int& R, int& C) { const int st = b / 1024, sb = b % 1024, swz = sb ^ (((sb >> 9) & 1) << 5); R = (st >> 1) * 16 + swz / 64; C = (st & 1) * 32 + (swz % 64) / 2; }
__host__ __device__ __forceinline__ int perm32(int rho) { const int n = rho >> 4, i = rho & 15; return 8 * (i >> 2) + 4 * n + (i & 3); }

struct Unit { int pm, pn, sub; };
struct Gemm { const bf16_t* A; const bf16_t* Bt; long sa, sb; int M, N, K; };
__device__ __forceinline__ const bf16_t* selA(const Gemm& g, int s) { return g.A + (long)s * g.sa; }
__device__ __forceinline__ const bf16_t* selB(const Gemm& g, int s) { return g.Bt + (long)s * g.sb; }

struct StaticOrder {
    int nM, nN, nwg, G, c;
    __host__ __device__ __forceinline__ void init(int M, int N, int G_, int c_) { nM = M / BM; nN = N / BM; nwg = nM * nN; G = G_; c = c_; }
    __host__ __device__ __forceinline__ bool next(int i, Unit& u) const {
        const long L = (long)i * G + c; if (L >= nwg) return false;
        int wgid = (int)L; { const int q = nwg / NXCD, r = nwg % NXCD, xcd = wgid % NXCD, off = wgid / NXCD; wgid = (xcd < r ? xcd * (q + 1) : r * (q + 1) + (xcd - r) * q) + off; }
        const int nig = WGM * nN, gid = wgid / nig, fm = gid * WGM, gsz = (nM - fm) < WGM ? (nM - fm) : WGM;
        u.pm = fm + ((wgid % nig) % gsz); u.pn = (wgid % nig) / gsz; u.sub = 0; return true;
    }
    __device__ __forceinline__ void a_ready(const Unit&) const {}
    __device__ __forceinline__ void done(const Unit&) const {}
};
struct ChainOrder {
    StaticOrder S;
    __device__ __forceinline__ bool next(int i, Unit& u) const { const int q = i / 3; if (!S.next(q, u)) return false; u.sub = i - 3 * q; return true; }
    __device__ __forceinline__ void a_ready(const Unit&) const {}
    __device__ __forceinline__ void done(const Unit&) const {}
};
__device__ __forceinline__ unsigned cvt_pk_bf16(float lo, float hi) { unsigned r; asm volatile("v_cvt_pk_bf16_f32 %0, %1, %2" : "=v"(r) : "v"(lo), "v"(hi)); return r; }

template <class Epi, class Sched, bool ALIGN_EPI = false, bool SP2 = false>
__device__ __forceinline__ void gemm_phase(PG8_LAS unsigned char* lds, const Gemm g, const Sched& S, const Epi& E) {
    int tid_raw = threadIdx.x; asm volatile("" : "+v"(tid_raw)); const int tid = tid_raw, wid = __builtin_amdgcn_readfirstlane(tid >> 6), lane = tid & 63, wr = wid >> 2, wc = wid & 3, fr = lane & 15, fq = lane >> 4;
    const int K = g.K, nt = K / BK;
    unsigned voffA[2], voffB[2];
#pragma unroll
    for (int i = 0; i < 2; ++i) { int R, C; stage_rc(tid * 16 + i * 8192, R, C); const int Rb = Epi::PERM ? ((R & ~31) + perm32(R & 31)) : R;
        voffA[i] = (unsigned)(R * K + C) * 2u; voffB[i] = (unsigned)(Rb * K + C) * 2u; }
    const size_t kstep = (size_t)(BK * 2);
    const size_t hstep = (size_t)HALF * K * 2;
    const size_t tstep = 2 * hstep;
    const unsigned ldsw = (unsigned)wid * 1024u;
    const int aoff = lds_byte(wr * 64 + fr, fq * 8), boff = lds_byte(wc * 32 + fr, fq * 8);
#define PG8_SA(b, h) (((b) * 2 + (h)) * HTB)
#define PG8_SB(b, h) ((4 + (b) * 2 + (h)) * HTB)
#define PG8_STAGE(bufoff, gbase, voff) do { _Pragma("unroll") for (int _i = 0; _i < 2; ++_i) \
        __builtin_amdgcn_global_load_lds((const unsigned*)((const char*)(gbase) + (voff)[_i]), (PG8_LAS unsigned*)(lds + (bufoff) + ldsw + _i * 8192), 16, 0, 0); } while (0)
#define PG8_LDA(dst, b, h) do { _Pragma("unroll") for (int m = 0; m < 4; ++m) _Pragma("unroll") for (int k = 0; k < 2; ++k) dst[m][k] = *(const PG8_LAS bf16x8*)(lds + PG8_SA(b, h) + aoff + m * 2048 + k * 1024); } while (0)
#define PG8_LDB(dst, b, h) do { _Pragma("unroll") for (int n = 0; n < 2; ++n) _Pragma("unroll") for (int k = 0; k < 2; ++k) dst[n][k] = *(const PG8_LAS bf16x8*)(lds + PG8_SB(b, h) + boff + n * 2048 + k * 1024); } while (0)
#define PG8_MMA(ai, bj, At, Bt) do { __builtin_amdgcn_s_setprio(1); _Pragma("unroll") for (int m = 0; m < 4; ++m) _Pragma("unroll") for (int n = 0; n < 2; ++n) _Pragma("unroll") for (int k = 0; k < 2; ++k) \
        acc[ai][bj][m][n] = __builtin_amdgcn_mfma_f32_16x16x32_bf16(Bt[n][k], At[m][k], acc[ai][bj][m][n], 0, 0, 0); __builtin_amdgcn_s_setprio(0); } while (0)
#define PG8_WAIT_V(n) asm volatile("s_waitcnt vmcnt(" #n ")" ::: "memory")
#define PG8_WAIT_L(n) asm volatile("s_waitcnt lgkmcnt(" #n ")" ::: "memory")
#define PG8_BAR __builtin_amdgcn_s_barrier()
#define PG8_SCHED __builtin_amdgcn_sched_barrier(0)
    Unit cur, nxt; int ui = 0;
    if (!S.next(0, cur)) return;
    f32x4 acc[2][2][4][2];
#pragma unroll
    for (int a = 0; a < 2; ++a)
#pragma unroll
        for (int b = 0; b < 2; ++b)
#pragma unroll
            for (int m = 0; m < 4; ++m)
#pragma unroll
                for (int n = 0; n < 2; ++n) acc[a][b][m][n] = (f32x4){0.f, 0.f, 0.f, 0.f};
    bf16x8 At[4][2], B0[2][2], B1[2][2];
    const char* cA = (const char*)selA(g, cur.sub) + (size_t)cur.pm * tstep; const char* cB = (const char*)selB(g, cur.sub) + (size_t)cur.pn * tstep;
    S.a_ready(cur);
    if constexpr (SP2) {
        PG8_STAGE(PG8_SB(0, 0), cB, voffB); PG8_STAGE(PG8_SB(0, 1), cB + hstep, voffB); PG8_STAGE(PG8_SA(0, 0), cA, voffA); PG8_STAGE(PG8_SA(0, 1), cA + hstep, voffA);
        if (wr == 1) PG8_BAR;
        PG8_WAIT_V(2); PG8_BAR;
        PG8_STAGE(PG8_SB(1, 0), cB + kstep, voffB); PG8_STAGE(PG8_SA(1, 0), cA + kstep, voffA); PG8_STAGE(PG8_SB(1, 1), cB + hstep + kstep, voffB);
        PG8_WAIT_V(6); PG8_BAR;
    } else {
        PG8_STAGE(PG8_SB(0, 0), cB, voffB); PG8_STAGE(PG8_SA(0, 0), cA, voffA); PG8_STAGE(PG8_SB(0, 1), cB + hstep, voffB); PG8_STAGE(PG8_SA(0, 1), cA + hstep, voffA);
        if (wr == 1) PG8_BAR;
        PG8_WAIT_V(4); PG8_BAR;
        PG8_STAGE(PG8_SB(1, 0), cB + kstep, voffB); PG8_STAGE(PG8_SA(1, 0), cA + kstep, voffA); PG8_STAGE(PG8_SB(1, 1), cB + hstep + kstep, voffB);
        PG8_WAIT_V(6); PG8_BAR;
    }
    for (;;) {
        const bool has_next = S.next(ui + 1, nxt);
        const char* nA = has_next ? (const char*)selA(g, nxt.sub) + (size_t)nxt.pm * tstep : cA; const char* nB = has_next ? (const char*)selB(g, nxt.sub) + (size_t)nxt.pn * tstep : cB;
        for (int t = 0; t < nt; t += 2) {
            const bool last = (t == nt - 2);
            const char* a1 = cA + (size_t)(t + 1) * kstep;
            const char* a2 = last ? nA : cA + (size_t)(t + 2) * kstep; const char* b2 = last ? nB : cB + (size_t)(t + 2) * kstep;
            const char* a3 = a2 + kstep; const char* b3 = b2 + kstep;
            if (last && has_next) S.a_ready(nxt);
            if constexpr (SP2) {
            PG8_LDB(B0, 0, 0); PG8_LDB(B1, 0, 1); PG8_SCHED; PG8_LDA(At, 0, 0); PG8_STAGE(PG8_SA(1, 1), a1 + hstep, voffA);
            PG8_WAIT_V(8); PG8_WAIT_L(0); PG8_BAR; PG8_MMA(0, 0, At, B0); PG8_MMA(0, 1, At, B1); PG8_BAR; PG8_SCHED;
            PG8_LDA(At, 0, 1); PG8_STAGE(PG8_SB(0, 0), b2, voffB); PG8_STAGE(PG8_SB(0, 1), b2 + hstep, voffB); PG8_STAGE(PG8_SA(0, 0), a2, voffA);
            PG8_WAIT_V(8); PG8_WAIT_L(0); PG8_BAR; PG8_MMA(1, 0, At, B0); PG8_MMA(1, 1, At, B1); PG8_BAR; PG8_SCHED;
            PG8_LDB(B0, 1, 0); PG8_LDB(B1, 1, 1); PG8_SCHED; PG8_LDA(At, 1, 0); PG8_STAGE(PG8_SA(0, 1), a2 + hstep, voffA);
            PG8_WAIT_V(8); PG8_WAIT_L(0); PG8_BAR; PG8_MMA(0, 0, At, B0); PG8_MMA(0, 1, At, B1); PG8_BAR; PG8_SCHED;
            PG8_LDA(At, 1, 1); PG8_STAGE(PG8_SB(1, 0), b3, voffB); PG8_STAGE(PG8_SB(1, 1), b3 + hstep, voffB); PG8_STAGE(PG8_SA(1, 0), a3, voffA);
            PG8_WAIT_V(8); PG8_WAIT_L(0); PG8_BAR; PG8_MMA(1, 0, At, B0); PG8_MMA(1, 1, At, B1); PG8_BAR; PG8_SCHED;
            } else {
            PG8_LDB(B0, 0, 0); PG8_SCHED; PG8_LDA(At, 0, 0); PG8_STAGE(PG8_SA(1, 1), a1 + hstep, voffA);
            PG8_WAIT_L(8); PG8_BAR; PG8_WAIT_L(0); PG8_MMA(0, 0, At, B0); PG8_BAR; PG8_SCHED;
            PG8_LDB(B1, 0, 1); PG8_STAGE(PG8_SB(0, 0), b2, voffB);
            PG8_BAR; PG8_WAIT_L(0); PG8_MMA(0, 1, At, B1); PG8_BAR;
            PG8_LDA(At, 0, 1); PG8_STAGE(PG8_SA(0, 0), a2, voffA);
            PG8_BAR; PG8_WAIT_L(0); PG8_MMA(1, 0, At, B0); PG8_BAR; PG8_SCHED;
            PG8_STAGE(PG8_SB(0, 1), b2 + hstep, voffB);
            PG8_WAIT_V(6); PG8_BAR; PG8_MMA(1, 1, At, B1); PG8_BAR;
            PG8_LDB(B0, 1, 0); PG8_SCHED; PG8_LDA(At, 1, 0); PG8_STAGE(PG8_SA(0, 1), a2 + hstep, voffA);
            PG8_WAIT_L(8); PG8_BAR; PG8_WAIT_L(0); PG8_MMA(0, 0, At, B0); PG8_BAR; PG8_SCHED;
            PG8_LDB(B1, 1, 1); PG8_STAGE(PG8_SB(1, 0), b3, voffB);
            PG8_BAR; PG8_WAIT_L(0); PG8_MMA(0, 1, At, B1); PG8_BAR;
            PG8_LDA(At, 1, 1); PG8_STAGE(PG8_SA(1, 0), a3, voffA);
            PG8_BAR; PG8_WAIT_L(0); PG8_MMA(1, 0, At, B0); PG8_BAR; PG8_SCHED;
            PG8_STAGE(PG8_SB(1, 1), b3 + hstep, voffB);
            PG8_WAIT_V(6); PG8_BAR; PG8_MMA(1, 1, At, B1); PG8_BAR;
            }
        }
        if constexpr (ALIGN_EPI) { if (wr == 0) PG8_BAR; }
        if constexpr (!Epi::AFTER_DRAIN) { E(acc, cur, wr, wc, fr, fq); S.done(cur); }
        if (!has_next) break;
        if (!(Epi::CHAIN && nxt.sub != 0))
#pragma unroll
        for (int a = 0; a < 2; ++a)
#pragma unroll
            for (int b = 0; b < 2; ++b)
#pragma unroll
                for (int m = 0; m < 4; ++m)
#pragma unroll
                    for (int n = 0; n < 2; ++n) acc[a][b][m][n] = (f32x4){0.f, 0.f, 0.f, 0.f};
        cur = nxt; cA = nA; cB = nB; ++ui;
        if constexpr (ALIGN_EPI) { if (wr == 1) PG8_BAR; }
    }
    PG8_WAIT_V(0);
    if constexpr (!ALIGN_EPI) { if (wr == 0) PG8_BAR; }
    PG8_BAR;
    if constexpr (Epi::AFTER_DRAIN) { E.fused(acc, cur, wr, wc, fr, fq, lds, wid, lane); S.done(cur); }
#undef PG8_SA
#undef PG8_SB
#undef PG8_STAGE
#undef PG8_LDA
#undef PG8_LDB
#undef PG8_MMA
#undef PG8_WAIT_V
#undef PG8_WAIT_L
#undef PG8_BAR
#undef PG8_SCHED
}

}

constexpr int NWAVES = 8;
constexpr int D = 1024, NBATCH = 8, SEQ = 4096, CTXL = 256, INW = 6656, FF = 2816;
constexpr int HB = 4;
constexpr int LROWS = HB * SEQ, CROWS = HB * CTXL, HROWS = LROWS + CROWS;
constexpr int TLAT = NBATCH * SEQ, TCTX = NBATCH * CTXL, TROWS = TLAT + TCTX;
constexpr int NMODC = 6 * D;

constexpr size_t MiB = 1u << 20;
constexpr size_t WS_BAR = 16 * 1024;
constexpr size_t WS_MOD = 64 * 1024;
constexpr size_t WS_RT = 512 * 1024;
constexpr size_t WS_W = 1 * MiB, WL_STRIDE = 35 * MiB;
constexpr size_t W_IN = 0, W_BA = 13 * MiB, W_BB = 14 * MiB, W_BC = 15 * MiB, W_O = 16 * MiB, W_GU = 18 * MiB, W_D = 29 * MiB, W_P = 34 * MiB + 512 * 1024;
constexpr size_t WS_HC = 71 * MiB;
constexpr size_t WS_XN = 79 * MiB;
constexpr size_t WS_U = 147 * MiB;
constexpr size_t U_QN = 0, U_KN = 17 * MiB, U_VT = 34 * MiB, U_VTC = 50 * MiB, U_QR = 51 * MiB, U_KR = 59 * MiB + 512 * 1024, U_KTF = 68 * MiB, U_KTFC = 76 * MiB,
                 U_KTB = 76 * MiB + 512 * 1024, U_KTBC = 84 * MiB + 512 * 1024, U_VTR = 85 * MiB, U_VTRC = 101 * MiB, U_GR = 102 * MiB, U_UP = 119 * MiB, U_G = 136 * MiB;
constexpr size_t WS_ARP = 385 * MiB;
constexpr size_t WS_ST = 436 * MiB, WS_PREV = 470 * MiB, WS_END = 487 * MiB;
constexpr size_t XN_HALF = 34 * MiB;
constexpr size_t WS_FX = WS_ARP;
constexpr size_t WS_HD = WS_U;

constexpr int LDS_BYTES = 131072 + 1024;

#define LAS __attribute__((address_space(3)))
typedef unsigned short bf16;
typedef short bf16x8 __attribute__((ext_vector_type(8)));
typedef float f32x4 __attribute__((ext_vector_type(4)));
typedef float f32x2 __attribute__((ext_vector_type(2)));
typedef unsigned u32x4 __attribute__((ext_vector_type(4)));
typedef unsigned u32x2 __attribute__((ext_vector_type(2)));
#ifndef ALIGN_SMALL
#define ALIGN_SMALL true
#endif
#ifndef WT8
#define WT8 0
#endif
#if WT8
#define ST8(p, w) __hip_atomic_store((unsigned long long*)(p), __builtin_bit_cast(unsigned long long, (w)), __ATOMIC_RELAXED, __HIP_MEMORY_SCOPE_AGENT)
#else
#define ST8(p, w) (*(u32x2*)(p) = (w))
#endif
#define MMA16(a, b, c) __builtin_amdgcn_mfma_f32_16x16x32_bf16(a, b, c, 0, 0, 0)
#define LOG2E 1.4426950408889634f

__device__ __forceinline__ unsigned pk2(float lo, float hi) { return pg8::cvt_pk_bf16(lo, hi); }
__device__ __forceinline__ float bflo(unsigned w) { return __uint_as_float(w << 16); }
__device__ __forceinline__ float bfhi(unsigned w) { return __uint_as_float(w & 0xffff0000u); }
__device__ __forceinline__ bf16x8 ld16(const bf16* p) { return *(const bf16x8*)p; }
__device__ __forceinline__ unsigned short bf1(float v) { return (unsigned short)(pk2(v, 0.f) & 0xffffu); }
__device__ __forceinline__ float wave_sum(float v) {
#pragma unroll
    for (int o = 1; o < 64; o <<= 1) v += __shfl_xor(v, o);
    return v;
}
__device__ __forceinline__ float lg2_of_logit(float logit) { return -log1pf(expf(-logit)) * LOG2E; }
__device__ __forceinline__ float enx(float g) { return __builtin_amdgcn_exp2f(__builtin_amdgcn_fmed3f(g, -30.f, 30.f) * -LOG2E); }
__device__ __forceinline__ float sigm(float g) { return __builtin_amdgcn_rcpf(1.f + enx(g)); }
__device__ __forceinline__ float sigratio(float a, float b) { return (1.f + enx(b)) * __builtin_amdgcn_rcpf(1.f + enx(a)); }

__device__ __forceinline__ float dppx1(float v) { return __builtin_bit_cast(float, __builtin_amdgcn_mov_dpp(__builtin_bit_cast(int, v), 0xB1, 0xF, 0xF, true)); }
__device__ __forceinline__ float dppx2(float v) { return __builtin_bit_cast(float, __builtin_amdgcn_mov_dpp(__builtin_bit_cast(int, v), 0x4E, 0xF, 0xF, true)); }
__device__ __forceinline__ f32x4 quad_transpose(f32x4 v, bool b0, bool b1) {
    const float r0 = dppx1(b0 ? v[0] : v[1]), r1 = dppx1(b0 ? v[2] : v[3]);
    const float x0 = b0 ? r0 : v[0], x1 = b0 ? v[1] : r0, x2 = b0 ? r1 : v[2], x3 = b0 ? v[3] : r1;
    const float q0 = dppx2(b1 ? x0 : x2), q1 = dppx2(b1 ? x1 : x3);
    f32x4 w; w[0] = b1 ? q0 : x0; w[1] = b1 ? q1 : x1; w[2] = b1 ? x2 : q0; w[3] = b1 ? x3 : q1; return w;
}

struct EpiInproj {
    static constexpr bool PERM = false, AFTER_DRAIN = false, CHAIN = false;
    unsigned char* U;
#define EPI_FENCE() asm volatile("" ::: "memory")
    __device__ __forceinline__ void operator()(f32x4 (&acc)[2][2][4][2], const pg8::Unit& u, int wr, int wc, int fr, int fq) const {
        const int pn = u.pn;
        const bool isctx = u.pm >= 64;
        const int bl = isctx ? (u.pm - 64) : (u.pm >> 4);
        const int nseq = isctx ? CTXL : SEQ;
        const int tb = (isctx ? 0 : ((u.pm & 15) * 256)) + wr * 64 + fr;
        const int rbase = u.pm * 256 + wr * 64 + fr;
        if (pn < 4 || pn >= 10) {
            bf16* dst; int ld = 512, c0;
            if (pn < 2) { dst = (bf16*)(U + U_QN); c0 = pn * 256; }
            else if (pn < 4) { dst = (bf16*)(U + U_KN); c0 = (pn - 2) * 256; }
            else if (pn < 12) { dst = (bf16*)(U + U_GR); c0 = (pn - 10) * 256; }
            else if (pn < 14) { dst = (bf16*)(U + U_UP); c0 = (pn - 12) * 256; }
            else { dst = (bf16*)(U + U_G); c0 = (pn - 14) * 256; ld = 3072; }
            bf16* rp0 = dst + (size_t)rbase * ld + c0 + wc * 32 + fq * 4;
#pragma unroll
            for (int ai = 0; ai < 2; ++ai)
#pragma unroll
                for (int m = 0; m < 4; ++m) { bf16* rp = rp0 + (size_t)(ai * 128 + m * 16) * ld;
#pragma unroll
                    for (int bj = 0; bj < 2; ++bj)
#pragma unroll
                        for (int n = 0; n < 2; ++n) { f32x4 v = acc[ai][bj][m][n]; if (pn >= 14) { v[0] = sigm(v[0]); v[1] = sigm(v[1]); v[2] = sigm(v[2]); v[3] = sigm(v[3]); }
                            u32x2 w; w.x = pk2(v[0], v[1]); w.y = pk2(v[2], v[3]); ST8(rp + bj * 128 + n * 16, w); }
                    EPI_FENCE(); }
        } else if (pn < 6 || pn >= 8) {
            const bool nav = pn < 6;
            bf16* dst = (bf16*)(U + (nav ? (isctx ? U_VTC : U_VT) : (isctx ? U_VTRC : U_VTR)));
            const int ccb = (nav ? (pn - 4) : (pn - 8)) * 256 + wc * 32 + fq * 4 + (fr & 3);
            const bool b0 = (fr & 1) != 0, b1 = (fr & 2) != 0;
            bf16* bp0 = dst + (size_t)(bl * 512 + ccb) * nseq + (tb - fr) + 4 * (fr >> 2);
#pragma unroll
            for (int bj = 0; bj < 2; ++bj)
#pragma unroll
                for (int n = 0; n < 2; ++n) { bf16* bp = bp0 + (size_t)(bj * 128 + n * 16) * nseq;
#pragma unroll
                    for (int ai = 0; ai < 2; ++ai)
#pragma unroll
                        for (int m = 0; m < 4; ++m) { const f32x4 w4 = quad_transpose(acc[ai][bj][m][n], b0, b1); u32x2 w; w.x = pk2(w4[0], w4[1]); w.y = pk2(w4[2], w4[3]); *(u32x2*)(bp + ai * 128 + m * 16) = w; }
                    EPI_FENCE(); }
        }
        else {
            bf16* rp0 = (bf16*)(U + (pn == 6 ? U_QR : U_KR)) + (size_t)rbase * 256 + wc * 32 + fq * 4;
#pragma unroll
            for (int ai = 0; ai < 2; ++ai)
#pragma unroll
                for (int m = 0; m < 4; ++m) { bf16* rp = rp0 + (size_t)(ai * 128 + m * 16) * 256;
#pragma unroll
                    for (int bj = 0; bj < 2; ++bj)
#pragma unroll
                        for (int n = 0; n < 2; ++n) { const f32x4 v = acc[ai][bj][m][n]; u32x2 w; w.x = pk2(v[0], v[1]); w.y = pk2(v[2], v[3]); ST8(rp + bj * 128 + n * 16, w); }
                    EPI_FENCE(); }
        }
    }
};

struct EpiNull { static constexpr bool PERM = false, AFTER_DRAIN = false, CHAIN = false; float* sink;
    __device__ __forceinline__ void operator()(f32x4 (&acc)[2][2][4][2], const pg8::Unit& u, int wr, int wc, int fr, int fq) const { f32x4 s = {0.f, 0.f, 0.f, 0.f};
#pragma unroll
        for (int a = 0; a < 2; ++a)
#pragma unroll
            for (int b = 0; b < 2; ++b)
#pragma unroll
                for (int m = 0; m < 4; ++m)
#pragma unroll
                    for (int n = 0; n < 2; ++n) s += acc[a][b][m][n];
        if (s[0] + s[1] + s[2] + s[3] == 1.2345e-33f) sink[0] = 1.f; } };

struct EpiMerge {
    static constexpr bool PERM = false, AFTER_DRAIN = false, CHAIN = true;
    const bf16* G; bf16* Mo;
    __device__ __forceinline__ void operator()(f32x4 (&acc)[2][2][4][2], const pg8::Unit& u, int wr, int wc, int fr, int fq) const {
        const int rbase = u.pm * 256 + wr * 64 + fr, c0 = u.pn * 256 + wc * 32 + fq * 4, sub = u.sub;
#pragma unroll
        for (int ai = 0; ai < 2; ++ai)
#pragma unroll
            for (int m = 0; m < 4; ++m) { const size_t row = (size_t)(rbase + ai * 128 + m * 16); const bf16* gp = G + row * 3072 + c0;
#pragma unroll
                for (int bj = 0; bj < 2; ++bj)
#pragma unroll
                    for (int n = 0; n < 2; ++n) { const int co = bj * 128 + n * 16; f32x4 v = acc[ai][bj][m][n];
                        if (sub < 2) { const u32x2 a = *(const u32x2*)(gp + sub * 1024 + co), b = *(const u32x2*)(gp + (sub + 1) * 1024 + co);
                            v[0] *= bflo(a.x) * __builtin_amdgcn_rcpf(bflo(b.x)); v[1] *= bfhi(a.x) * __builtin_amdgcn_rcpf(bfhi(b.x)); v[2] *= bflo(a.y) * __builtin_amdgcn_rcpf(bflo(b.y)); v[3] *= bfhi(a.y) * __builtin_amdgcn_rcpf(bfhi(b.y));
                            acc[ai][bj][m][n] = v; }
                        else { const u32x2 a = *(const u32x2*)(gp + 2048 + co);
                            v[0] *= bflo(a.x); v[1] *= bfhi(a.x); v[2] *= bflo(a.y); v[3] *= bfhi(a.y);
                            u32x2 w; w.x = pk2(v[0], v[1]); w.y = pk2(v[2], v[3]); ST8(Mo + row * 1024 + c0 + co, w); } } }
    }
};

struct EpiResid {
    static constexpr bool PERM = false, AFTER_DRAIN = false, CHAIN = false;
    const float* base_lat; const float* base_ctx; float* out_lat; float* out_ctx; const float* mod; int lat_tiles, off_lat, off_ctx;
    __device__ __forceinline__ void operator()(f32x4 (&acc)[2][2][4][2], const pg8::Unit& u, int wr, int wc, int fr, int fq) const {
        const bool isctx = u.pm >= lat_tiles;
        const int r0 = (isctx ? off_ctx + (u.pm - lat_tiles) * 256 : off_lat + u.pm * 256);
        const int bidx = isctx ? 8 : (r0 >> 12);
        const float* bp = isctx ? base_ctx : base_lat; float* op = isctx ? out_ctx : out_lat;
        const int c0 = u.pn * 256 + wc * 32 + fq * 4;
        f32x4 mv[2][2];
#pragma unroll
        for (int bj = 0; bj < 2; ++bj)
#pragma unroll
            for (int n = 0; n < 2; ++n) mv[bj][n] = *(const f32x4*)(mod + bidx * NMODC + c0 + bj * 128 + n * 16);
#pragma unroll
        for (int ai = 0; ai < 2; ++ai)
#pragma unroll
            for (int m = 0; m < 4; ++m) { const size_t off = (size_t)(r0 + wr * 64 + fr + ai * 128 + m * 16) * D + c0;
#pragma unroll
                for (int bj = 0; bj < 2; ++bj)
#pragma unroll
                    for (int n = 0; n < 2; ++n) { const f32x4 b = *(const f32x4*)(bp + off + bj * 128 + n * 16); *(f32x4*)(op + off + bj * 128 + n * 16) = b + mv[bj][n] * acc[ai][bj][m][n]; } }
    }
};

struct EpiFfn1 {
    static constexpr bool PERM = false, AFTER_DRAIN = false, CHAIN = false;
    bf16* Hd;
    __device__ __forceinline__ void operator()(f32x4 (&acc)[2][2][4][2], const pg8::Unit& u, int wr, int wc, int fr, int fq) const {
        const int rbase = u.pm * 256 + wr * 64 + fr;
#pragma unroll
        for (int ai = 0; ai < 2; ++ai)
#pragma unroll
            for (int m = 0; m < 4; ++m) { bf16* rp = Hd + (size_t)(rbase + ai * 128 + m * 16) * FF + (u.pn * 256 + wc * 32) / 2 + fq * 4;
#pragma unroll
                for (int bj = 0; bj < 2; ++bj) { const f32x4 g = acc[ai][bj][m][0], up = acc[ai][bj][m][1]; f32x4 h;
#pragma unroll
                    for (int j = 0; j < 4; ++j) h[j] = g[j] * sigm(g[j]) * up[j];
                    u32x2 w; w.x = pk2(h[0], h[1]); w.y = pk2(h[2], h[3]); ST8(rp + bj * 64, w); } }
    }
};

struct Args { const float* in[23]; float* out; unsigned char* ws; int ph_lo, ph_hi; };

__device__ __forceinline__ void transpose_item(const float* W, int K, int N, bf16* WT, int mode, LAS float* scr, int item, int lane) {
    const int nblk = N / 32, kb = item / nblk, nb = item % nblk, k0 = 64 * kb, n0 = 32 * nb;
#pragma unroll 8
    for (int i = 0; i < 32; ++i) { const int kk = 2 * i + (lane >> 5); scr[kk * 33 + (lane & 31)] = W[(size_t)(k0 + kk) * N + n0 + (lane & 31)]; }
    asm volatile("s_waitcnt lgkmcnt(0)" ::: "memory");
    const int c = lane & 7;
#pragma unroll
    for (int j = 0; j < 4; ++j) { const int n = (lane >> 3) + 8 * j; const LAS float* s = scr + (8 * c) * 33 + n;
        u32x4 o; o.x = pk2(s[0 * 33], s[1 * 33]); o.y = pk2(s[2 * 33], s[3 * 33]); o.z = pk2(s[4 * 33], s[5 * 33]); o.w = pk2(s[6 * 33], s[7 * 33]);
        const int nn = n0 + n; const int dr = (mode == 0) ? nn : (nn + 16 * (nn >> 4) + (mode == 2 ? 16 : 0));
        *(u32x4*)(WT + (size_t)dr * K + k0 + 8 * c) = o; }
    asm volatile("s_waitcnt lgkmcnt(0)" ::: "memory");
}

__device__ __forceinline__ void norm_row(const float* src, bf16* dst, const float* gam, const float* shift, const float* scale, int lane) {
    f32x4 v[4]; float ss = 0.f;
#pragma unroll
    for (int j = 0; j < 4; ++j) { v[j] = *(const f32x4*)(src + 4 * lane + 256 * j); ss += (v[j][0] * v[j][0] + v[j][1] * v[j][1]) + (v[j][2] * v[j][2] + v[j][3] * v[j][3]); }
    const float rstd = rsqrtf(wave_sum(ss) * (1.f / D) + 1e-6f);
#pragma unroll
    for (int j = 0; j < 4; ++j) { const int c = 4 * lane + 256 * j; const f32x4 g = *(const f32x4*)(gam + c), sh = *(const f32x4*)(shift + c), sc = *(const f32x4*)(scale + c);
        const f32x4 y = (v[j] * rstd * g) * (sc + 1.0f) + sh; u32x2 w; w.x = pk2(y[0], y[1]); w.y = pk2(y[2], y[3]); ST8(dst + c, w); }
}

__device__ __forceinline__ void rope_item(unsigned char* U, const float* RT, float l2f, float l2b, int row0, int h, int which, int hf0, int lane) {
    const bool isctx = row0 >= LROWS;
    const int row = row0 + lane;
    bf16* p = (bf16*)(U + (which == 0 ? U_QR : U_KR)) + (size_t)row * 256 + h * 64;
    int t, bl, n; if (!isctx) { t = row & (SEQ - 1); bl = row >> 12; n = SEQ; } else { t = (row - LROWS) & (CTXL - 1); bl = (row - LROWS) >> 8; n = CTXL; }
    const int prow = isctx ? 0 : (t >> 6), pcol = isctx ? 0 : (t & 63);
    const float sc = which == 0 ? 1.0f : 0.125f;
    const int pc = t & 127; const float wf = __builtin_amdgcn_exp2f(l2f * (float)(127 - pc)), wb = __builtin_amdgcn_exp2f(l2b * (float)pc);
    bf16* kf = (bf16*)(U + (isctx ? U_KTFC : U_KTF)) + (size_t)((bl * 4 + h) * 64) * n + t;
    bf16* kb = (bf16*)(U + (isctx ? U_KTBC : U_KTB)) + (size_t)((bl * 4 + h) * 64) * n + t;
    { const int hf = hf0;
        const int pos = hf == 0 ? prow : pcol;
        u32x4 w0 = *(const u32x4*)(p + hf * 32), w1 = *(const u32x4*)(p + hf * 32 + 8), w2 = *(const u32x4*)(p + hf * 32 + 16), w3 = *(const u32x4*)(p + hf * 32 + 24);
        float x1[16], x2[16];
#pragma unroll
        for (int i = 0; i < 4; ++i) { x1[2 * i] = bflo(w0[i]); x1[2 * i + 1] = bfhi(w0[i]); x1[8 + 2 * i] = bflo(w1[i]); x1[8 + 2 * i + 1] = bfhi(w1[i]);
            x2[2 * i] = bflo(w2[i]); x2[2 * i + 1] = bfhi(w2[i]); x2[8 + 2 * i] = bflo(w3[i]); x2[8 + 2 * i + 1] = bfhi(w3[i]); }
#pragma unroll
        for (int i = 0; i < 16; ++i) { const f32x2 cs = *(const f32x2*)(RT + (pos * 16 + i) * 2); const float a = x1[i], b = x2[i];
            x1[i] = (a * cs[0] - b * cs[1]) * sc; x2[i] = (a * cs[1] + b * cs[0]) * sc; }
#pragma unroll
        for (int i = 0; i < 4; ++i) { w0[i] = pk2(x1[2 * i], x1[2 * i + 1]); w1[i] = pk2(x1[8 + 2 * i], x1[8 + 2 * i + 1]); w2[i] = pk2(x2[2 * i], x2[2 * i + 1]); w3[i] = pk2(x2[8 + 2 * i], x2[8 + 2 * i + 1]); }
        *(u32x4*)(p + hf * 32) = w0; *(u32x4*)(p + hf * 32 + 8) = w1; *(u32x4*)(p + hf * 32 + 16) = w2; *(u32x4*)(p + hf * 32 + 24) = w3;
        if (which == 1) {
#pragma unroll
            for (int i = 0; i < 16; ++i) { kf[(size_t)(hf * 32 + i) * n] = bf1(x1[i] * wf); kb[(size_t)(hf * 32 + i) * n] = bf1(x1[i] * wb);
                kf[(size_t)(hf * 32 + 16 + i) * n] = bf1(x2[i] * wf); kb[(size_t)(hf * 32 + 16 + i) * n] = bf1(x2[i] * wb); }
        }
        EPI_FENCE();
    }
}

struct NaState { f32x4 o[4]; float mrun, l; };
template <bool ISW>
__device__ __forceinline__ void na_block(NaState& S, const bf16x8 q0, const bf16x8 q1, const bf16* Kp0, const bf16* vb, const LAS unsigned char* kl, const LAS unsigned char* vl,
                                         const LAS float* rp0, int kstart, int qc, int ws_, int fq) {
    f32x4 st[8];
    bf16x8 vw[16];
    if (ISW) {
        bf16x8 kw[16];
#pragma unroll
        for (int t = 0; t < 8; ++t) { const bf16* Kp = Kp0 + (size_t)((t >> 1) * 64 + 4 * (t & 1)) * 512; kw[2 * t] = ld16(Kp); kw[2 * t + 1] = ld16(Kp + 32); }
#pragma unroll
        for (int gi = 0; gi < 4; ++gi)
#pragma unroll
            for (int dt = 0; dt < 4; ++dt) vw[gi * 4 + dt] = ld16(vb + (size_t)dt * 16 * SEQ + gi * 64);
#pragma unroll
        for (int t = 0; t < 8; ++t) { f32x4 z = {0.f, 0.f, 0.f, 0.f}; z = MMA16(kw[2 * t], q0, z); z = MMA16(kw[2 * t + 1], q1, z); st[t] = z; }
    } else {
#pragma unroll
        for (int t = 0; t < 8; ++t) { f32x4 z = {0.f, 0.f, 0.f, 0.f};
            z = MMA16(*(const LAS bf16x8*)(kl + t * 16 * 144), q0, z); z = MMA16(*(const LAS bf16x8*)(kl + t * 16 * 144 + 64), q1, z); st[t] = z; }
    }
    float mx = -1e30f;
#pragma unroll
    for (int t = 0; t < 8; ++t) {
#pragma unroll
        for (int j = 0; j < 4; ++j) { float s = st[t][j] * (0.125f * LOG2E);
            if (ISW) { const int kc = kstart + 8 * fq + 4 * (t & 1) + j; const bool ok = (kc >= ws_) && (kc < ws_ + 16); const int dc = min(max(kc - qc + 15, 0), 30);
                s += rp0[(t >> 1) * 31 + dc]; s = ok ? s : -1e30f; }
            st[t][j] = s; mx = fmaxf(mx, s); } }
    mx = fmaxf(mx, __shfl_xor(mx, 16)); mx = fmaxf(mx, __shfl_xor(mx, 32));
    const float mnew = fmaxf(S.mrun, mx), resc = __builtin_amdgcn_exp2f(S.mrun - mnew);
    S.mrun = mnew; float ls = 0.f;
#pragma unroll
    for (int t = 0; t < 8; ++t)
#pragma unroll
        for (int j = 0; j < 4; ++j) { const float p = __builtin_amdgcn_exp2f(st[t][j] - mnew); st[t][j] = p; ls += p; }
    ls += __shfl_xor(ls, 16); ls += __shfl_xor(ls, 32);
    S.l = S.l * resc + ls;
#pragma unroll
    for (int dt = 0; dt < 4; ++dt) S.o[dt] = S.o[dt] * resc;
#pragma unroll
    for (int gi = 0; gi < 4; ++gi) { u32x4 pw; pw.x = pk2(st[2 * gi][0], st[2 * gi][1]); pw.y = pk2(st[2 * gi][2], st[2 * gi][3]); pw.z = pk2(st[2 * gi + 1][0], st[2 * gi + 1][1]); pw.w = pk2(st[2 * gi + 1][2], st[2 * gi + 1][3]);
        const bf16x8 pf = __builtin_bit_cast(bf16x8, pw);
        if (ISW) {
#pragma unroll
            for (int dt = 0; dt < 4; ++dt) S.o[dt] = MMA16(vw[gi * 4 + dt], pf, S.o[dt]);
        } else {
#pragma unroll
            for (int dt = 0; dt < 4; ++dt) S.o[dt] = MMA16(*(const LAS bf16x8*)(vl + dt * 16 * 528 + gi * 64), pf, S.o[dt]);
        } }
}
__device__ __forceinline__ void na_block_lw(NaState& S, const bf16x8 q0, const bf16x8 q1, const LAS unsigned char* Kl, const LAS unsigned char* Vl, const LAS float* rph,
                                            int rowb, int grow, int r0, int kstart, int qc, int ws_, int fr, int fq) {
    f32x4 st[8];
    const LAS unsigned char* kl = Kl + (size_t)(kstart + 8 * (fr >> 2) + (fr & 3)) * 144 + fq * 16;
#pragma unroll
    for (int t = 0; t < 8; ++t) { const LAS unsigned char* kp = kl + ((t >> 1) * 64 + 4 * (t & 1)) * 144; f32x4 z = {0.f, 0.f, 0.f, 0.f};
        z = MMA16(*(const LAS bf16x8*)kp, q0, z); z = MMA16(*(const LAS bf16x8*)(kp + 64), q1, z); st[t] = z; }
    float mx = -1e30f;
#pragma unroll
    for (int t = 0; t < 8; ++t) { const int kra = rowb + (t >> 1); const bool rowok = (kra >= r0) && (kra <= r0 + 7); const int dr = min(max(kra - grow + 7, 0), 14);
        const LAS float* rpr = rph + dr * 31;
#pragma unroll
        for (int j = 0; j < 4; ++j) { const int kc = kstart + 8 * fq + 4 * (t & 1) + j; const bool ok = rowok && (kc >= ws_) && (kc < ws_ + 16); const int dc = min(max(kc - qc + 15, 0), 30);
            float s = st[t][j] * (0.125f * LOG2E) + rpr[dc]; s = ok ? s : -1e30f; st[t][j] = s; mx = fmaxf(mx, s); } }
    mx = fmaxf(mx, __shfl_xor(mx, 16)); mx = fmaxf(mx, __shfl_xor(mx, 32));
    const float mnew = fmaxf(S.mrun, mx), resc = __builtin_amdgcn_exp2f(S.mrun - mnew);
    S.mrun = mnew; float ls = 0.f;
#pragma unroll
    for (int t = 0; t < 8; ++t)
#pragma unroll
        for (int j = 0; j < 4; ++j) { const float p = __builtin_amdgcn_exp2f(st[t][j] - mnew); st[t][j] = p; ls += p; }
    ls += __shfl_xor(ls, 16); ls += __shfl_xor(ls, 32);
    S.l = S.l * resc + ls;
#pragma unroll
    for (int dt = 0; dt < 4; ++dt) S.o[dt] = S.o[dt] * resc;
    const LAS unsigned char* vl = Vl + (size_t)fr * 528 + (kstart + 8 * fq) * 2;
#pragma unroll
    for (int gi = 0; gi < 4; ++gi) { u32x4 pw; pw.x = pk2(st[2 * gi][0], st[2 * gi][1]); pw.y = pk2(st[2 * gi][2], st[2 * gi][3]); pw.z = pk2(st[2 * gi + 1][0], st[2 * gi + 1][1]); pw.w = pk2(st[2 * gi + 1][2], st[2 * gi + 1][3]);
        const bf16x8 pf = __builtin_bit_cast(bf16x8, pw);
#pragma unroll
        for (int dt = 0; dt < 4; ++dt) S.o[dt] = MMA16(*(const LAS bf16x8*)(vl + dt * 16 * 528 + gi * 128), pf, S.o[dt]); }
}
template <bool WIN>
__device__ __forceinline__ void na_item(unsigned char* U, bf16* Aout, const LAS float* rp, const LAS unsigned char* Kl, const LAS unsigned char* Vl, int bl, int h, int qrow0, int grow, int cb, int lane) {
    const int fr = lane & 15, fq = lane >> 4;
    const bf16* QN = (const bf16*)(U + U_QN); const bf16* KN = (const bf16*)(U + U_KN); const bf16* VT = (const bf16*)(U + U_VT);
    const bf16* Qp = QN + (size_t)(qrow0 + fr) * 512 + h * 64 + fq * 8;
    const bf16x8 q0 = ld16(Qp), q1 = ld16(Qp + 32);
    const int r0 = min(max(grow - 4, 0), 56), kstart = min(max(16 * cb - 8, 0), 32), koff = 8 * (fr >> 2) + (fr & 3);
    const int qc = 16 * cb + fr, ws_ = min(max(qc - 8, 0), 48);
    NaState S;
#pragma unroll
    for (int dt = 0; dt < 4; ++dt) S.o[dt] = (f32x4){0.f, 0.f, 0.f, 0.f};
    S.mrun = -1e30f; S.l = 0.f;
    if (WIN) {
#pragma unroll 1
        for (int blk = 0; blk < 2; ++blk) {
            const bf16* Kp0 = KN + (size_t)(bl * SEQ + (r0 + 4 * blk) * 64 + kstart + koff) * 512 + h * 64 + fq * 8;
            const bf16* vb = VT + (size_t)((bl * 8 + h) * 64 + fr) * SEQ + (r0 + 4 * blk) * 64 + kstart + 8 * fq;
            na_block<true>(S, q0, q1, Kp0, vb, Kl, Vl, rp + (h * 15 + (r0 + 4 * blk - grow + 7)) * 31, kstart, qc, ws_, fq);
            EPI_FENCE();
        }
    }
#pragma unroll 1
    for (int blk = 0; blk < 2; ++blk) {
        na_block<false>(S, q0, q1, KN, VT, Kl + (size_t)(128 * blk + fr) * 144 + fq * 16, Vl + (size_t)fr * 528 + (128 * blk + 8 * fq) * 2, rp, 0, 0, 0, fq);
        EPI_FENCE();
    }
    const float inv = 1.f / S.l;
    bf16* op = Aout + (size_t)(qrow0 + fr) * 512 + h * 64 + 4 * fq;
#pragma unroll
    for (int dt = 0; dt < 4; ++dt) { u32x2 w; w.x = pk2(S.o[dt][0] * inv, S.o[dt][1] * inv); w.y = pk2(S.o[dt][2] * inv, S.o[dt][3] * inv); ST8(op + dt * 16, w); }
}

template <int GI>
__device__ __forceinline__ void pool_item(unsigned char* U, const bf16* PW, const float* pscale, bf16* Pout, int row0, int lane) {
    constexpr int g = GI, W = 2 << GI, hw = 1 << GI;
    const int fr = lane & 15, fq = lane >> 4;
    const bf16* UP = (const bf16*)(U + U_UP);
    const int row = row0 + fr;
    int t, n; if (row < LROWS) { t = row & (SEQ - 1); n = SEQ; } else { t = (row - LROWS) & (CTXL - 1); n = CTXL; }
    const int sbase = row - t;
    const int lo = max(t - hw, 0), hi = min(t + hw, n);
    const float inv = 1.f / (float)(hi - lo);
    f32x4 acc[8];
#pragma unroll
    for (int dt = 0; dt < 8; ++dt) acc[dt] = (f32x4){0.f, 0.f, 0.f, 0.f};
#pragma unroll
    for (int ks = 0; ks < 4; ++ks) { const int c0 = g * 128 + ks * 32 + fq * 8;
        float s0 = 0.f, s1 = 0.f, s2 = 0.f, s3 = 0.f, s4 = 0.f, s5 = 0.f, s6 = 0.f, s7 = 0.f;
        constexpr int WC = W < 8 ? W : 8;
        const u32x4 me = *(const u32x4*)(UP + (size_t)row * 512 + c0);
#pragma unroll
        for (int i0 = 0; i0 < W; i0 += WC) {
            u32x4 wv[WC];
#pragma unroll
            for (int i = 0; i < WC; ++i) { const int tt = min(max(t - hw + i0 + i, 0), n - 1); wv[i] = *(const u32x4*)(UP + (size_t)(sbase + tt) * 512 + c0); }
#pragma unroll
            for (int i = 0; i < WC; ++i) { const int tt = t - hw + i0 + i; const float ok = (tt >= 0 && tt < n) ? 1.f : 0.f; const u32x4 v = wv[i];
                s0 += ok * bflo(v.x); s1 += ok * bfhi(v.x); s2 += ok * bflo(v.y); s3 += ok * bfhi(v.y); s4 += ok * bflo(v.z); s5 += ok * bfhi(v.z); s6 += ok * bflo(v.w); s7 += ok * bfhi(v.w); }
            EPI_FENCE();
        }
        u32x4 pw; pw.x = pk2(s0 * inv - bflo(me.x), s1 * inv - bfhi(me.x)); pw.y = pk2(s2 * inv - bflo(me.y), s3 * inv - bfhi(me.y));
        pw.z = pk2(s4 * inv - bflo(me.z), s5 * inv - bfhi(me.z)); pw.w = pk2(s6 * inv - bflo(me.w), s7 * inv - bfhi(me.w));
        const bf16x8 pf = __builtin_bit_cast(bf16x8, pw);
        EPI_FENCE();
#pragma unroll
        for (int dt = 0; dt < 8; ++dt) { const bf16x8 wf = ld16(PW + (size_t)(g * 128 + dt * 16 + fr) * 128 + ks * 32 + fq * 8); acc[dt] = MMA16(wf, pf, acc[dt]); if ((dt & 3) == 3) EPI_FENCE(); }
        }
#pragma unroll
    for (int dt = 0; dt < 8; ++dt) { const int col = g * 128 + dt * 16 + 4 * fq; const f32x4 sc = *(const f32x4*)(pscale + col); const f32x4 y = acc[dt] * sc;
        u32x2 w; w.x = pk2(y[0], y[1]); w.y = pk2(y[2], y[3]); ST8(Pout + (size_t)row * 512 + col, w); }
}

__device__ __forceinline__ void contrib_item(unsigned char* U, float* ST, int bl, int h, bool isctx, int C, int dvt, int lane) {
    const int fr = lane & 15, fq = lane >> 4;
    const int n = isctx ? CTXL : SEQ;
    const bf16* VTR = (const bf16*)(U + (isctx ? U_VTRC : U_VTR));
    bf16x8 vf[4];
#pragma unroll
    for (int ks = 0; ks < 4; ++ks) vf[ks] = ld16(VTR + (size_t)((bl * 4 + h) * 128 + dvt * 16 + fr) * n + C * 128 + ks * 32 + fq * 8);
#pragma unroll
    for (int dir = 0; dir < 2; ++dir) {
        const bf16* KT = (const bf16*)(U + (dir == 0 ? (isctx ? U_KTFC : U_KTF) : (isctx ? U_KTBC : U_KTB)));
        const int step = dir == 0 ? (isctx ? C : 2 + C) : (isctx ? 1 - C : 2 + 31 - C);
        float* sp = ST + ((size_t)(((bl * 4 + h) * 2 + dir) * 34 + step)) * 8192 + (dvt * 16 + 4 * fq) * 64 + fr;
#pragma unroll
        for (int dkt = 0; dkt < 4; ++dkt) { f32x4 a = {0.f, 0.f, 0.f, 0.f};
#pragma unroll
            for (int ks = 0; ks < 4; ++ks) { const bf16x8 kf = ld16(KT + (size_t)((bl * 4 + h) * 64 + dkt * 16 + fr) * n + C * 128 + ks * 32 + fq * 8); a = MMA16(vf[ks], kf, a); }
#pragma unroll
            for (int j = 0; j < 4; ++j) sp[j * 64 + dkt * 16] = a[j];
            EPI_FENCE(); }
    }
}

constexpr int RO_K = 0, RO_V = 18432, RO_PF = 18432 + 34816, RO_PB = RO_PF + 18432, RO_END = RO_PB + 18432;
__device__ __forceinline__ void retout_item(unsigned char* U, const LAS unsigned char* L, bf16* Rout, const float* gn, float l2f, float l2b, int bl, int h, bool isctx, int C, int qt, int lane) {
    const int fr = lane & 15, fq = lane >> 4;
    const int rowbase = isctx ? (LROWS + bl * CTXL) : bl * SEQ;
    const bf16* QR = (const bf16*)(U + U_QR); const bf16* GR = (const bf16*)(U + U_GR);
    const int row = rowbase + C * 128 + qt * 16 + fr;
    const bf16* Qp = QR + (size_t)row * 256 + h * 64 + fq * 8;
    const bf16x8 q0 = ld16(Qp), q1 = ld16(Qp + 32);
    const int nq = qt * 16 + fr;
    f32x4 st[8];
    const LAS unsigned char* kl = L + RO_K + fr * 144 + fq * 16;
#pragma unroll
    for (int t = 0; t < 8; ++t) {
        f32x4 z = {0.f, 0.f, 0.f, 0.f}; z = MMA16(*(const LAS bf16x8*)(kl + t * 16 * 144), q0, z); z = MMA16(*(const LAS bf16x8*)(kl + t * 16 * 144 + 64), q1, z);
#pragma unroll
        for (int j = 0; j < 4; ++j) { const int mm = 32 * (t >> 1) + 8 * fq + 4 * (t & 1) + j; const int dl = nq - mm; const float w = __builtin_amdgcn_exp2f(dl >= 0 ? l2f * (float)dl : l2b * (float)(-dl)); z[j] *= w; }
        st[t] = z; }
    f32x4 o[8];
#pragma unroll
    for (int dt = 0; dt < 8; ++dt) o[dt] = (f32x4){0.f, 0.f, 0.f, 0.f};
    const LAS unsigned char* vl = L + RO_V + fr * 272 + fq * 16;
#pragma unroll
    for (int gi = 0; gi < 4; ++gi) { u32x4 pw; pw.x = pk2(st[2 * gi][0], st[2 * gi][1]); pw.y = pk2(st[2 * gi][2], st[2 * gi][3]); pw.z = pk2(st[2 * gi + 1][0], st[2 * gi + 1][1]); pw.w = pk2(st[2 * gi + 1][2], st[2 * gi + 1][3]);
        const bf16x8 pf = __builtin_bit_cast(bf16x8, pw);
#pragma unroll
        for (int dt = 0; dt < 8; ++dt) o[dt] = MMA16(*(const LAS bf16x8*)(vl + dt * 16 * 272 + gi * 64), pf, o[dt]);
        EPI_FENCE(); }
    const float xf = __builtin_amdgcn_exp2f(l2f * (float)(nq + 1)), xb = __builtin_amdgcn_exp2f(l2b * (float)(128 - nq));
    const LAS unsigned char* pfl = L + RO_PF + fr * 144 + fq * 16; const LAS unsigned char* pbl = L + RO_PB + fr * 144 + fq * 16;
#pragma unroll
    for (int dt = 0; dt < 8; ++dt) { f32x4 cf = {0.f, 0.f, 0.f, 0.f}, cb = {0.f, 0.f, 0.f, 0.f};
        cf = MMA16(*(const LAS bf16x8*)(pfl + dt * 16 * 144), q0, cf); cf = MMA16(*(const LAS bf16x8*)(pfl + dt * 16 * 144 + 64), q1, cf);
        cb = MMA16(*(const LAS bf16x8*)(pbl + dt * 16 * 144), q0, cb); cb = MMA16(*(const LAS bf16x8*)(pbl + dt * 16 * 144 + 64), q1, cb);
        o[dt] = o[dt] + cf * xf + cb * xb; if (dt & 1) EPI_FENCE(); }
    float s = 0.f;
#pragma unroll
    for (int dt = 0; dt < 8; ++dt) s += (o[dt][0] + o[dt][1]) + (o[dt][2] + o[dt][3]);
    s += __shfl_xor(s, 16); s += __shfl_xor(s, 32);
    const float mu = s * (1.f / 128.f); float q = 0.f;
#pragma unroll
    for (int dt = 0; dt < 8; ++dt) { const f32x4 d = o[dt] - mu; q += (d[0] * d[0] + d[1] * d[1]) + (d[2] * d[2] + d[3] * d[3]); }
    q += __shfl_xor(q, 16); q += __shfl_xor(q, 32);
    const float rstd = rsqrtf(q * (1.f / 128.f) + 1e-5f);
#pragma unroll
    for (int dt = 0; dt < 8; ++dt) { const int col = h * 128 + dt * 16 + 4 * fq; const f32x4 gg = *(const f32x4*)(gn + col); const u32x2 gw = *(const u32x2*)(GR + (size_t)row * 512 + col);
        const float g0 = bflo(gw.x), g1 = bfhi(gw.x), g2 = bflo(gw.y), g3 = bfhi(gw.y);
        const f32x4 y = (o[dt] - mu) * rstd * gg;
        u32x2 w; w.x = pk2(g0 * sigm(g0) * y[0], g1 * sigm(g1) * y[1]); w.y = pk2(g2 * sigm(g2) * y[2], g3 * sigm(g3) * y[3]);
        ST8(Rout + (size_t)row * 512 + col, w); }
}

#define RLX_AGENT __ATOMIC_RELAXED, __HIP_MEMORY_SCOPE_AGENT
#define XB_TMO      128
#define XB_XCNT(j)  (256  + 64 * (j))
#define XB_XSUB(j)  (1280 + 64 * (j))
#define XB_XGEN(j)  (2304 + 64 * (j))
#define XB_TOP      3328
#define XB_TOPGEN   3392
#define XCD_BAR_WORDS 3456
#define XB_SPIN_CAP (1u << 18)

__device__ __forceinline__ unsigned xb_ld(unsigned* p)              { return __hip_atomic_load(p, __ATOMIC_RELAXED, __HIP_MEMORY_SCOPE_AGENT); }
__device__ __forceinline__ unsigned xb_add(unsigned* p, unsigned v) { return __hip_atomic_fetch_add(p, v, __ATOMIC_RELAXED, __HIP_MEMORY_SCOPE_AGENT); }
__device__ __forceinline__ unsigned xb_xcc_id() { return (unsigned)__builtin_amdgcn_s_getreg((3 << 11) | 20) & 0xFu; }
#define XB_SPIN(cond, bar) do { unsigned _sp = 0; while (cond) { __builtin_amdgcn_s_sleep(1); \
    if ((++_sp & 255u) == 0u) { if (xb_ld(&(bar)[XB_TMO])) break; if (_sp > XB_SPIN_CAP) { atomicAdd(&(bar)[XB_TMO], 1u); break; } } } } while (0)

struct XcdBarrier {
    unsigned* bar; unsigned x;
    volatile LAS unsigned* st;
};

__device__ __forceinline__ XcdBarrier xcd_barrier_post(unsigned* bar, volatile LAS unsigned* st) {
    XcdBarrier b; b.bar = bar; b.x = xb_xcc_id(); b.st = st;
    if (threadIdx.x == 0) (void)xb_add(&bar[XB_XCNT(b.x)], 1u);
    return b;
}
__device__ __forceinline__ void xcd_barrier_complete(unsigned* bar, unsigned x, unsigned& nloc, unsigned& nx) {
    const unsigned G = gridDim.x * gridDim.y * gridDim.z;
    unsigned sum, cnt, mine, sp = 0u;
    for (;;) {
        sum = 0u; cnt = 0u; mine = 0u;
#pragma unroll
        for (unsigned j = 0; j < 16; ++j) { const unsigned c = xb_ld(&bar[XB_XCNT(j)]); sum += c; cnt += (c > 0u) ? 1u : 0u; mine = (j == x) ? c : mine; }
        if (sum == G) break;
        __builtin_amdgcn_s_sleep(1);
        if ((++sp & 255u) == 0u) { if (xb_ld(&bar[XB_TMO])) break; if (sp > XB_SPIN_CAP) { atomicAdd(&bar[XB_TMO], 1u); break; } }
    }
    nloc = mine > 0u ? mine : 1u; nx = cnt > 0u ? cnt : 1u;
}

__device__ __forceinline__ void xcd_barrier(const XcdBarrier& b) {
    asm volatile("s_waitcnt vmcnt(0)" ::: "memory");
    __syncthreads();
    if (threadIdx.x == 0) {
        unsigned* bar = b.bar;
        __builtin_amdgcn_s_waitcnt(0);
        unsigned nloc = b.st[0], nx = b.st[1];
        if (nloc == 0u) { xcd_barrier_complete(bar, b.x, nloc, nx); b.st[0] = nloc; b.st[1] = nx; }
        const unsigned old = xb_add(&bar[XB_XSUB(b.x)], 1u);
        const unsigned gen = old / nloc;
        if (old + 1u == (gen + 1u) * nloc) {
            __builtin_amdgcn_fence(__ATOMIC_RELEASE, "agent");
            asm volatile("s_waitcnt vmcnt(0)" ::: "memory");
            const unsigned og = xb_add(&bar[XB_TOP], 1u);
            const unsigned tg = og / nx;
            if (og + 1u == (tg + 1u) * nx) xb_add(&bar[XB_TOPGEN], 1u);
            else XB_SPIN(xb_ld(&bar[XB_TOPGEN]) == tg, bar);
            __builtin_amdgcn_fence(__ATOMIC_ACQUIRE, "agent");
            xb_add(&bar[XB_XGEN(b.x)], 1u);
            asm volatile("s_waitcnt vmcnt(0)" ::: "memory");
        } else {
            XB_SPIN(xb_ld(&bar[XB_XGEN(b.x)]) == gen, bar);
            __builtin_amdgcn_fence(__ATOMIC_ACQUIRE, "agent");
            asm volatile("s_waitcnt vmcnt(0)" ::: "memory");
        }
    }
    __syncthreads();
}

__global__ void __launch_bounds__(NWAVES * 64, 2) fwd_megakernel(Args args) {
    extern __shared__ __attribute__((aligned(16))) unsigned char lds_raw[];
    LAS unsigned char* lds = (LAS unsigned char*)lds_raw;
    cg::grid_group grid = cg::this_grid();
    const int tid0 = threadIdx.x, wave = __builtin_amdgcn_readfirstlane(tid0 >> 6);
    const int G = gridDim.x, gw = blockIdx.x * NWAVES + wave, NGW = G * NWAVES;
    unsigned char* ws = args.ws;
    const float* x = args.in[0]; const float* cvec = args.in[1]; const float* ctx = args.in[2]; const float* cctx = args.in[3];
    float* out = args.out; float* HC = (float*)(ws + WS_HC);
    float* MOD = (float*)(ws + WS_MOD); float* RT = (float*)(ws + WS_RT);
    unsigned char* U = ws + WS_U;
    const int lo = args.ph_lo, hi = args.ph_hi;
    int pid = 0;
    if (tid0 < 64) ((LAS unsigned*)(lds + 131072))[tid0] = 0u;
    if (blockIdx.x == 0 && lo == 0) { unsigned* bw = (unsigned*)(ws + WS_BAR); for (int i = tid0; i < XCD_BAR_WORDS; i += NWAVES * 64) __hip_atomic_store(bw + i, 0u, __ATOMIC_RELAXED, __HIP_MEMORY_SCOPE_AGENT); }
    __syncthreads();
    XcdBarrier xbar; xbar.bar = (unsigned*)(ws + WS_BAR); xbar.x = 0; xbar.st = nullptr;
#define PH_BEGIN if (pid >= lo && pid < hi) { int tid = tid0; asm volatile("" : "+v"(tid)); const int lane = tid & 63; (void)lane;
#define PH_END } if (pid >= lo && pid + 1 < hi) { if (pid == 0) { grid.sync(); xbar = xcd_barrier_post((unsigned*)(ws + WS_BAR), (volatile LAS unsigned*)(lds + 131072)); } else { for (int s_ = 0; s_ < NSYNC; ++s_) xcd_barrier(xbar); } } ++pid;

    PH_BEGIN
#ifndef OFF0
#pragma unroll 1
            for (int rep_ = 0; rep_ < REP0; ++rep_) {
    {
        LAS float* sv = (LAS float*)lds;
        LAS float* red = (LAS float*)(lds + 40960);
        for (int i = tid; i < 9 * D; i += NWAVES * 64) { const float v = (i < 8 * D) ? cvec[i] : cctx[i - 8 * D]; sv[i] = v / (1.f + expf(-v)); }
        __syncthreads();
        for (int item = blockIdx.x; item < 2 * 96; item += G) {
            const int l = item / 96, col = (item % 96) * 64 + lane;
            const float* wa = args.in[6] + (size_t)l * D * NMODC + col;
            float a[9];
#pragma unroll
            for (int b = 0; b < 9; ++b) a[b] = 0.f;
#pragma unroll 16
            for (int kk = 0; kk < 128; ++kk) { const int k = wave * 128 + kk; const float wv = wa[(size_t)k * NMODC];
#pragma unroll
                for (int b = 0; b < 9; ++b) a[b] += sv[b * D + k] * wv; }
#pragma unroll
            for (int b = 0; b < 9; ++b) red[(wave * 9 + b) * 64 + lane] = a[b];
            __syncthreads();
            for (int o = tid; o < 9 * 64; o += NWAVES * 64) { const int b = o >> 6, ln = o & 63; float s = 0.f;
#pragma unroll
                for (int w = 0; w < 8; ++w) s += red[(w * 9 + b) * 64 + ln];
                const int cc = (item % 96) * 64 + ln; MOD[((size_t)l * 9 + b) * NMODC + cc] = s + args.in[7][(size_t)l * NMODC + cc]; }
            __syncthreads();
        }
        if (blockIdx.x == G - 1) { for (int i = tid; i < 64 * 16; i += NWAVES * 64) { const int pos = i >> 4, f = i & 15; const float inv = powf(10000.f, -(float)f / 16.f); const float ang = (float)pos * inv;
            RT[2 * i] = cosf(ang); RT[2 * i + 1] = sinf(ang); } }
        __syncthreads();
        LAS float* scr = (LAS float*)(lds + wave * 16384);
        constexpr int I_IN = 16 * (INW / 32), I_BR = 8 * 32, I_O = 16 * 32, I_G = 16 * (FF / 32), I_D = (FF / 64) * 32, I_P = 2 * 4;
        constexpr int I_LAYER = I_IN + 3 * I_BR + I_O + 2 * I_G + I_D + 4 * I_P;
        for (int it = gw; it < 2 * I_LAYER; it += NGW) {
            const int l = it / I_LAYER; int r = it - l * I_LAYER; unsigned char* wl = ws + WS_W + (size_t)l * WL_STRIDE;
            if (r < I_IN) { transpose_item(args.in[8] + (size_t)l * D * INW, D, INW, (bf16*)(wl + W_IN), 0, scr, r, lane); continue; } r -= I_IN;
            if (r < I_BR) { transpose_item(args.in[15] + (size_t)l * 512 * D, 512, D, (bf16*)(wl + W_BA), 0, scr, r, lane); continue; } r -= I_BR;
            if (r < I_BR) { transpose_item(args.in[16] + (size_t)l * 512 * D, 512, D, (bf16*)(wl + W_BB), 0, scr, r, lane); continue; } r -= I_BR;
            if (r < I_BR) { transpose_item(args.in[17] + (size_t)l * 512 * D, 512, D, (bf16*)(wl + W_BC), 0, scr, r, lane); continue; } r -= I_BR;
            if (r < I_O) { transpose_item(args.in[18] + (size_t)l * D * D, D, D, (bf16*)(wl + W_O), 0, scr, r, lane); continue; } r -= I_O;
            if (r < I_G) { transpose_item(args.in[19] + (size_t)l * D * FF, D, FF, (bf16*)(wl + W_GU), 1, scr, r, lane); continue; } r -= I_G;
            if (r < I_G) { transpose_item(args.in[20] + (size_t)l * D * FF, D, FF, (bf16*)(wl + W_GU), 2, scr, r, lane); continue; } r -= I_G;
            if (r < I_D) { transpose_item(args.in[21] + (size_t)l * FF * D, FF, D, (bf16*)(wl + W_D), 0, scr, r, lane); continue; } r -= I_D;
            { const int g = r / I_P; transpose_item(args.in[13] + ((size_t)l * 4 + g) * 128 * 128, 128, 128, (bf16*)(wl + W_P) + (size_t)g * 128 * 128, 0, scr, r % I_P, lane); }
        }
        __syncthreads();
    }
            }
#endif
    PH_END

#pragma unroll 1
    for (int l = 0; l < 2; ++l) {
        const bool with_ctx = (l == 0);
        unsigned char* wl = ws + WS_W + (size_t)l * WL_STRIDE;
        const float* modl = MOD + (size_t)l * 9 * NMODC;
        const float* hl = (l == 0) ? x : out; const float* hcs = (l == 0) ? ctx : HC;
        PH_BEGIN
#ifndef OFF1
#pragma unroll 1
            for (int rep_ = 0; rep_ < REP1; ++rep_) {
            for (int rr = gw; rr < 2 * HROWS; rr += NGW) {
                const int g = rr >= HROWS ? 1 : 0, r = rr - g * HROWS;
                const float* src; int bidx;
                if (r < LROWS) { const int gr = g * LROWS + r; src = hl + (size_t)gr * D; bidx = gr >> 12; } else { const int gc = g * CROWS + (r - LROWS); src = hcs + (size_t)gc * D; bidx = 8; }
                norm_row(src, (bf16*)(ws + WS_XN) + (size_t)rr * D, args.in[4] + l * D, modl + bidx * NMODC, modl + bidx * NMODC + D, lane);
            }
            }
#endif
        PH_END
#pragma unroll 1
        for (int s = 0; s < 3; ++s) {
            PH_BEGIN
            if (s == 2) {
                const int g = 1;
                const int Mr = with_ctx ? HROWS : LROWS;
                pg8::Gemm gm{(const bf16*)(ws + WS_XN + g * XN_HALF), (const bf16*)(wl + W_O), 0, 0, Mr, D, D};
                pg8::StaticOrder S; S.init(Mr, D, G, (int)blockIdx.x);
                EpiResid E{hl, hcs, out, HC, modl + 2 * D, LROWS / 256, g * LROWS, g * CROWS};
                pg8::gemm_phase<EpiResid, pg8::StaticOrder, ALIGN_SMALL, true>(lds, gm, S, E);
            }
            if (s == 2) {
                for (int q = NGW - 1 - gw; q < (with_ctx ? HROWS : LROWS); q += NGW) {
                    const int r = q < LROWS ? q : TLAT + (q - LROWS);
                    const float* src; int bidx;
                    if (r < TLAT) { src = out + (size_t)r * D; bidx = r >> 12; } else { src = HC + (size_t)(r - TLAT) * D; bidx = 8; }
                    norm_row(src, (bf16*)(ws + WS_FX) + (size_t)r * D, args.in[5] + l * D, modl + bidx * NMODC + 3 * D, modl + bidx * NMODC + 4 * D, lane);
                }
            }
            if (s < 2) {
                const int g = s;
                pg8::Gemm gm{(const bf16*)(ws + WS_XN + g * XN_HALF), (const bf16*)(wl + W_IN), 0, 0, HROWS, INW, D};
                pg8::StaticOrder S; S.init(HROWS, INW, G, s == 0 ? (int)blockIdx.x : G - 1 - (int)blockIdx.x);
                EpiInproj E{U};
                pg8::gemm_phase<EpiInproj, pg8::StaticOrder, true, true>(lds, gm, S, E);
            }
            PH_END
            if (s < 2) {
            const int g = s;
            PH_BEGIN
#ifndef OFF3
#pragma unroll 1
            for (int rep_ = 0; rep_ < REP3; ++rep_) {
            {
                constexpr int NA_K_OFF = 0, NA_V_OFF = 36864, NA_RP_OFF = 36864 + 33792;
                LAS float* rp = (LAS float*)(lds + NA_RP_OFF);
                for (int i = tid; i < 8 * 15 * 31; i += NWAVES * 64) rp[i] = args.in[9][(size_t)l * 8 * 15 * 31 + i] * LOG2E;
                bf16* Aout = (bf16*)(ws + WS_ARP); bf16* Pout = (bf16*)(ws + WS_ARP + 34 * MiB);
                const int vcu = (G % 8 == 0) ? ((int)blockIdx.x % 8) * (G / 8) + (int)blockIdx.x / 8 : (int)blockIdx.x;
                const int nb_na = HB * 8 * 8, nb_nac = 0;
#ifndef M1_NO_NA
#pragma unroll 1
                for (int bi = vcu; bi < nb_na; bi += G) {
                    const int rg = bi & 7, h = (bi >> 3) & 7, bl = bi >> 6, R = rg * 8;
                    const int fr = lane & 15, fq = lane >> 4, cb = wave & 3, rw = R + (wave >> 2) * 4;
                    const int kstart = min(max(16 * cb - 8, 0), 32), qc = 16 * cb + fr, ws_ = min(max(qc - 8, 0), 48);
                    NaState S4[4];
                    const bf16* Qp0 = (const bf16*)(U + U_QN) + (size_t)(bl * SEQ + rw * 64 + cb * 16 + fr) * 512 + h * 64 + fq * 8;
                    __syncthreads();
                    {
                        const bf16* KN = (const bf16*)(U + U_KN) + (size_t)(LROWS + bl * CTXL) * 512 + h * 64; const bf16* VTC = (const bf16*)(U + U_VTC) + (size_t)((bl * 8 + h) * 64) * CTXL;
#pragma unroll
                        for (int i = 0; i < 4; ++i) { const int ch = tid + i * 512; const int key = ch >> 3, c = ch & 7;
                            const int rho = (key & ~31) + 16 * ((key >> 2) & 1) + 4 * ((key >> 3) & 3) + (key & 3);
                            *(LAS u32x4*)(lds + NA_K_OFF + rho * 144 + c * 16) = *(const u32x4*)(KN + (size_t)key * 512 + c * 8); }
#pragma unroll
                        for (int i = 0; i < 4; ++i) { const int ch = tid + i * 512; const int d = ch >> 5, c = ch & 31;
                            *(LAS u32x4*)(lds + NA_V_OFF + d * 528 + c * 16) = *(const u32x4*)(VTC + (size_t)d * CTXL + c * 8); }
                    }
                    __syncthreads();
                    if (with_ctx && wave < 2)
                        na_item<false>(U, Aout, rp, lds + NA_K_OFF, lds + NA_V_OFF, bl, h, LROWS + bl * CTXL + (rg * 2 + wave) * 16, 0, 0, lane);
                    EPI_FENCE();
#pragma unroll
                    for (int i = 0; i < 4; ++i) {
#pragma unroll
                        for (int dt = 0; dt < 4; ++dt) S4[i].o[dt] = (f32x4){0.f, 0.f, 0.f, 0.f};
                        S4[i].mrun = -1e30f; S4[i].l = 0.f; }
#pragma unroll
                    for (int i = 0; i < 4; ++i) {
#pragma unroll 1
                        for (int blk = 0; blk < 2; ++blk) { na_block<false>(S4[i], ld16(Qp0 + (size_t)i * 64 * 512), ld16(Qp0 + (size_t)i * 64 * 512 + 32), nullptr, nullptr, lds + NA_K_OFF + (size_t)(128 * blk + fr) * 144 + fq * 16, lds + NA_V_OFF + (size_t)fr * 528 + (128 * blk + 8 * fq) * 2, rp, 0, 0, 0, fq); EPI_FENCE(); } }
#pragma unroll 1
                    for (int kb = 0; kb < 4; ++kb) {
                        const int rowb = R - 4 + 4 * kb;
                        if (rowb + 3 < 0 || rowb > 63) continue;
                        __syncthreads();
                        {
                            const bf16* KNb = (const bf16*)(U + U_KN) + (size_t)(bl * SEQ) * 512 + h * 64; const bf16* VTb = (const bf16*)(U + U_VT) + (size_t)((bl * 8 + h) * 64) * SEQ;
#pragma unroll
                            for (int i = 0; i < 4; ++i) { const int ch = tid + i * 512; const int key = ch >> 3, c = ch & 7; const int row = min(max(rowb + (key >> 6), 0), 63);
                                *(LAS u32x4*)(lds + NA_K_OFF + key * 144 + c * 16) = *(const u32x4*)(KNb + (size_t)(row * 64 + (key & 63)) * 512 + c * 8); }
#pragma unroll
                            for (int i = 0; i < 4; ++i) { const int ch = tid + i * 512; const int d = ch >> 5, krl = (ch >> 3) & 3, c = ch & 7; const int row = min(max(rowb + krl, 0), 63);
                                *(LAS u32x4*)(lds + NA_V_OFF + d * 528 + (krl * 64 + c * 8) * 2) = *(const u32x4*)(VTb + (size_t)d * SEQ + row * 64 + c * 8); }
                        }
                        __syncthreads();
#pragma unroll
                        for (int i = 0; i < 4; ++i) { const int grow = rw + i, r0 = min(max(grow - 4, 0), 56);
                            if (rowb + 3 >= r0 && rowb <= r0 + 7) {
                                na_block_lw(S4[i], ld16(Qp0 + (size_t)i * 64 * 512), ld16(Qp0 + (size_t)i * 64 * 512 + 32), lds + NA_K_OFF, lds + NA_V_OFF, rp + h * 15 * 31, rowb, grow, r0, kstart, qc, ws_, fr, fq); EPI_FENCE(); } }
                    }
#pragma unroll
                    for (int i = 0; i < 4; ++i) { const float inv = 1.f / S4[i].l; bf16* op = Aout + (size_t)(bl * SEQ + (rw + i) * 64 + cb * 16 + fr) * 512 + h * 64 + 4 * fq;
#pragma unroll
                        for (int dt = 0; dt < 4; ++dt) { u32x2 w; w.x = pk2(S4[i].o[dt][0] * inv, S4[i].o[dt][1] * inv); w.y = pk2(S4[i].o[dt][2] * inv, S4[i].o[dt][3] * inv); ST8(op + dt * 16, w); } }
                }
#endif
                const int n_pt = (with_ctx ? HROWS : LROWS) / 16, n_con = HB * 4 * 34 * 8;
#pragma unroll 1
                for (int rpc_ = 0; rpc_ < REP_PC; ++rpc_) {
#ifndef M1_NO_POOL
                    const bf16* PWp = (const bf16*)(wl + W_P); const float* psc = args.in[14] + l * 512;
#pragma unroll 1
                    for (int rpool_ = 0; rpool_ < REP_POOL; ++rpool_) {
#pragma unroll 1
                    for (int it = gw; it < n_pt; it += NGW) pool_item<3>(U, PWp, psc, Pout, it * 16, lane);
                    EPI_FENCE();
#pragma unroll 1
                    for (int it = (gw + NGW / 2) % NGW; it < n_pt; it += NGW) pool_item<2>(U, PWp, psc, Pout, it * 16, lane);
                    EPI_FENCE();
#pragma unroll 1
                    for (int it = (gw + NGW / 4) % NGW; it < n_pt; it += NGW) pool_item<1>(U, PWp, psc, Pout, it * 16, lane);
                    EPI_FENCE();
#pragma unroll 1
                    for (int it = (gw + 3 * NGW / 4) % NGW; it < n_pt; it += NGW) pool_item<0>(U, PWp, psc, Pout, it * 16, lane);
                    EPI_FENCE();
                    }
#endif
#ifndef M1_NO_CON
#pragma unroll 1
                    for (int bi = blockIdx.x; bi < HB * 4 * 34; bi += G) {
                        const int ch = bi % 34, bh = bi / 34, h = bh & 3, bl = bh >> 2; const bool ic = ch < 2; const int C = ic ? ch : ch - 2;
                        { const int row0 = (ic ? LROWS + bl * CTXL : bl * SEQ) + C * 128 + ((wave >> 1) & 1) * 64;
                            rope_item(U, RT, lg2_of_logit(args.in[10][l * 4 + h]), lg2_of_logit(args.in[11][l * 4 + h]), row0, h, wave & 1, wave >> 2, lane); }
                        asm volatile("s_waitcnt vmcnt(0)" ::: "memory");
                        __syncthreads();
                        contrib_item(U, (float*)(ws + WS_ST), bl, h, ic, C, wave, lane);
                    }
#endif
                }
                __syncthreads();
            }
            }
#endif
            PH_END
            PH_BEGIN
#ifndef OFF4
#pragma unroll 1
            for (int rep_ = 0; rep_ < REP4; ++rep_) {
            {
                const float* STp = (const float*)(ws + WS_ST); bf16* PV = (bf16*)(ws + WS_PREV);
                for (int idx = blockIdx.x * (NWAVES * 64) + tid; idx < 16 * 2 * 8192; idx += G * NWAVES * 64) {
                    const int e = idx & 8191, sd = idx >> 13, dir = sd & 1, h = (sd >> 1) & 3;
                    const float l2 = lg2_of_logit(dir == 0 ? args.in[10][l * 4 + h] : args.in[11][l * 4 + h]);
                    const float gC = exp2f(l2 * 128.f);
                    float s = 0.f; const size_t base = (size_t)sd * 34 * 8192 + e;
float cv[34];
#pragma unroll
                    for (int stp = 0; stp < 34; ++stp) cv[stp] = STp[base + (size_t)stp * 8192];
#pragma unroll
                    for (int stp = 0; stp < 34; ++stp) { PV[base + (size_t)stp * 8192] = bf1(s); s = s * gC + cv[stp]; }
                }
            }
            }
#endif
            PH_END
            PH_BEGIN
#ifndef OFF5
#pragma unroll 1
            for (int rep_ = 0; rep_ < REP5; ++rep_) {
            {
                bf16* Rout = (bf16*)(ws + WS_ARP + 17 * MiB);
                const int nch = with_ctx ? 34 : 32;
                const bf16* PREV = (const bf16*)(ws + WS_PREV);
                for (int bi = blockIdx.x; bi < 16 * nch; bi += G) {
                    int ch = bi % nch; const int bh = bi / nch; const int h = bh & 3, bl = bh >> 2;
                    bool ic = false; if (with_ctx) { ic = ch < 2; ch = ic ? ch : ch - 2; }
                    const int n = ic ? CTXL : SEQ; const int rowbase = ic ? (LROWS + bl * CTXL) : bl * SEQ;
                    const int stepf = ic ? ch : 2 + ch, stepb = ic ? 1 - ch : 2 + 31 - ch;
                    const bf16* KR = (const bf16*)(U + U_KR) + (size_t)(rowbase + ch * 128) * 256 + h * 64;
                    const bf16* VTR = (const bf16*)(U + (ic ? U_VTRC : U_VTR)) + (size_t)((bl * 4 + h) * 128) * n + ch * 128;
                    const bf16* Pf = PREV + ((size_t)(((bl * 4 + h) * 2 + 0) * 34 + stepf)) * 8192; const bf16* Pb = PREV + ((size_t)(((bl * 4 + h) * 2 + 1) * 34 + stepb)) * 8192;
                    __syncthreads();
#pragma unroll
                    for (int i = 0; i < 2; ++i) { const int cx = tid + i * 512; const int key = cx >> 3, c = cx & 7;
                        const int rho = (key & ~31) + 16 * ((key >> 2) & 1) + 4 * ((key >> 3) & 3) + (key & 3);
                        *(LAS u32x4*)(lds + RO_K + rho * 144 + c * 16) = *(const u32x4*)(KR + (size_t)key * 256 + c * 8);
                        *(LAS u32x4*)(lds + RO_PF + key * 144 + c * 16) = *(const u32x4*)(Pf + key * 64 + c * 8);
                        *(LAS u32x4*)(lds + RO_PB + key * 144 + c * 16) = *(const u32x4*)(Pb + key * 64 + c * 8); }
#pragma unroll
                    for (int i = 0; i < 4; ++i) { const int cx = tid + i * 512; const int dv = cx >> 4, c = cx & 15;
                        *(LAS u32x4*)(lds + RO_V + dv * 272 + c * 16) = *(const u32x4*)(VTR + (size_t)dv * n + c * 8); }
                    __syncthreads();
                    const float l2f = lg2_of_logit(args.in[10][l * 4 + h]), l2b = lg2_of_logit(args.in[11][l * 4 + h]);
                    retout_item(U, lds, Rout, args.in[12] + l * 512, l2f, l2b, bl, h, ic, ch, wave, lane);
                }
                __syncthreads();
            }
            }
#endif
            PH_END
            PH_BEGIN
#ifndef OFF6
#pragma unroll 1
            for (int rep_ = 0; rep_ < REP6; ++rep_) {
            {
                const int Mr = with_ctx ? HROWS : LROWS;
                pg8::Gemm gm{(const bf16*)(ws + WS_ARP), (const bf16*)(wl + W_BA), (long)(17 * MiB / 2), (long)(1 * MiB / 2), Mr, D, 512};
                pg8::ChainOrder S; S.S.init(Mr, D, G, (int)blockIdx.x);
                EpiMerge E{(const bf16*)(U + U_G), (bf16*)(ws + WS_XN + g * XN_HALF)};
                pg8::gemm_phase<EpiMerge, pg8::ChainOrder, ALIGN_SMALL, true>(lds, gm, S, E);
                if (g == 1) {
                    const int skip = with_ctx ? 16 : 0;
                    if ((int)blockIdx.x >= skip) {
                        pg8::Gemm gw_{(const bf16*)(ws + WS_XN), (const bf16*)(wl + W_O), 0, 0, Mr, D, D};
                        pg8::StaticOrder SW; SW.init(Mr, D, G - skip, (int)blockIdx.x - skip);
                        EpiResid EW{hl, hcs, out, HC, modl + 2 * D, LROWS / 256, 0, 0};
                        pg8::gemm_phase<EpiResid, pg8::StaticOrder, ALIGN_SMALL, true>(lds, gw_, SW, EW);
                    }
                }
            }
            }
#endif
            PH_END
            }
        }
        const int Mf = with_ctx ? TROWS : TLAT;
        PH_BEGIN
#ifndef OFF8
#pragma unroll 1
            for (int rep_ = 0; rep_ < REP8; ++rep_) {
        for (int q = gw; q < (with_ctx ? HROWS : LROWS); q += NGW) {
            const int r = q < LROWS ? LROWS + q : TLAT + CROWS + (q - LROWS);
            const float* src; int bidx;
            if (r < TLAT) { src = out + (size_t)r * D; bidx = r >> 12; } else { src = HC + (size_t)(r - TLAT) * D; bidx = 8; }
            norm_row(src, (bf16*)(ws + WS_FX) + (size_t)r * D, args.in[5] + l * D, modl + bidx * NMODC + 3 * D, modl + bidx * NMODC + 4 * D, lane);
        }
            }
#endif
        PH_END
        PH_BEGIN
#ifndef OFF9
#pragma unroll 1
            for (int rep_ = 0; rep_ < REP9; ++rep_) {
        {
            pg8::Gemm gm{(const bf16*)(ws + WS_FX), (const bf16*)(wl + W_GU), 0, 0, Mf, 2 * FF, D};
            pg8::StaticOrder S; S.init(Mf, 2 * FF, G, (int)blockIdx.x);
            EpiFfn1 E{(bf16*)(ws + WS_HD)};
            pg8::gemm_phase<EpiFfn1, pg8::StaticOrder, true, true>(lds, gm, S, E);
        }
            }
#endif
        PH_END
        PH_BEGIN
#ifndef OFF10
#pragma unroll 1
            for (int rep_ = 0; rep_ < REP10; ++rep_) {
        {
            pg8::Gemm gm{(const bf16*)(ws + WS_HD), (const bf16*)(wl + W_D), 0, 0, Mf, D, FF};
            pg8::StaticOrder S; S.init(Mf, D, G, (int)blockIdx.x);
            EpiResid E{out, HC, out, HC, modl + 5 * D, TLAT / 256, 0, 0};
            pg8::gemm_phase<EpiResid, pg8::StaticOrder, ALIGN_SMALL, true>(lds, gm, S, E);
        }
            }
#endif
        PH_END
    }
    PH_BEGIN
#ifndef OFF11
#pragma unroll 1
            for (int rep_ = 0; rep_ < REP11; ++rep_) {
    for (int r = gw; r < TLAT; r += NGW) {
        float* p = out + (size_t)r * D; f32x4 v[4]; float ss = 0.f;
#pragma unroll
        for (int j = 0; j < 4; ++j) { v[j] = *(const f32x4*)(p + 4 * lane + 256 * j); ss += (v[j][0] * v[j][0] + v[j][1] * v[j][1]) + (v[j][2] * v[j][2] + v[j][3] * v[j][3]); }
        const float rstd = rsqrtf(wave_sum(ss) * (1.f / D) + 1e-6f);
#pragma unroll
        for (int j = 0; j < 4; ++j) { const int c = 4 * lane + 256 * j; *(f32x4*)(p + c) = v[j] * rstd * *(const f32x4*)(args.in[22] + c); }
    }
            }
#endif
    PH_END
#undef PH_BEGIN
#undef PH_END
}
constexpr int N_PHASES = 1 + 2 * (1 + 3 + 2 * 4 + 3) + 1;

extern "C" void kernel_launch(void* const* d_in, const int* in_sizes, int n_in, void* d_out, int out_size, void* d_ws, size_t ws_size, hipStream_t stream) {
    static int grid = 0;
    if (grid == 0) {
        if (n_in != 23 || in_sizes[0] != TLAT * D || out_size != TLAT * D || ws_size < WS_END) { fprintf(stderr, "kernel_launch: unexpected shapes / workspace (n_in %d, ws %zu)\n", n_in, ws_size); grid = -1; return; }
        int dev = 0, cus = 0, per_cu = 0;
        if (hipGetDevice(&dev) != hipSuccess || hipDeviceGetAttribute(&cus, hipDeviceAttributeMultiprocessorCount, dev) != hipSuccess) { grid = -1; return; }
        if (hipFuncSetAttribute((const void*)fwd_megakernel, hipFuncAttributeMaxDynamicSharedMemorySize, LDS_BYTES) != hipSuccess) { fprintf(stderr, "kernel_launch: hipFuncSetAttribute failed\n"); grid = -1; return; }
        if (hipOccupancyMaxActiveBlocksPerMultiprocessor(&per_cu, (const void*)fwd_megakernel, NWAVES * 64, LDS_BYTES) != hipSuccess || per_cu < 1) { fprintf(stderr, "kernel_launch: occupancy query says %d\n", per_cu); per_cu = 1; }
        (void)hipGetLastError();
        grid = cus * 1;
    }
    if (grid < 0) return;
    Args a{};
    for (int i = 0; i < 23; ++i) a.in[i] = (const float*)d_in[i];
    a.out = (float*)d_out; a.ws = (unsigned char*)d_ws;
#if MK_PER_PHASE
    for (int p = 0; p < N_PHASES; ++p) { a.ph_lo = p; a.ph_hi = p + 1; void* kargs[] = {&a};
        hipError_t e = hipLaunchCooperativeKernel((const void*)fwd_megakernel, dim3(grid), dim3(NWAVES * 64), kargs, LDS_BYTES, stream);
        if (e != hipSuccess) { fprintf(stderr, "launch %d failed: %s\n", p, hipGetErrorString(e)); break; } }
#else
    a.ph_lo = 0; a.ph_hi = N_PHASES;
    void* kargs[] = {&a};
    hipError_t e = hipLaunchCooperativeKernel((const void*)fwd_megakernel, dim3(grid), dim3(NWAVES * 64), kargs, LDS_BYTES, stream);
    if (e != hipSuccess) fprintf(stderr, "cooperative launch failed: %s (grid %d)\n", hipGetErrorString(e), grid);
#endif
}
```
